# Optimizing an MI355X kernel written in HIP

```python
import math
import jax, jax.numpy as jnp
from jax import lax
import numpy as np

D_MODEL = 1024
BATCH = 16
SEQ = 2048
DEPTH = 1

MEM_LEN = 256
D_S5 = D_MODEL // 2
D_LRU = D_MODEL - D_S5
S5_GROUP = 16
S5_GROUPS = D_S5 // S5_GROUP
S5_STATE = 64
LRU_HEADS = 8
LRU_HEAD_DIM = D_LRU // LRU_HEADS
CONV_WIDTH = 4
LRU_C = 8.0
D_FF = 4 * D_MODEL
CA_HEADS = 4
CA_HEAD_DIM = D_MODEL // CA_HEADS
D_IN = D_S5 + 2 * D_LRU
ALPHA = (2 * DEPTH) ** 0.25
BETA = (8 * DEPTH) ** -0.25
LN_EPS = 1e-5
RMS_EPS = 1e-6

kernel_name = "hymba_s5_rglru_deepnorm_memxattn"


def layer_norm(x, g, b):
    xf = x.astype(jnp.float32)
    mu = jnp.mean(xf, axis=-1, keepdims=True)
    var = jnp.mean(jnp.square(xf - mu), axis=-1, keepdims=True)
    return ((xf - mu) * lax.rsqrt(var + LN_EPS) * g + b).astype(x.dtype)


def rms_norm(x, g):
    xf = x.astype(jnp.float32)
    ms = jnp.mean(jnp.square(xf), axis=-1, keepdims=True)
    return (xf * lax.rsqrt(ms + RMS_EPS) * g).astype(x.dtype)


def _complex_diag_combine(left, right):
    a1r, a1i, b1r, b1i = left
    a2r, a2i, b2r, b2i = right
    ar = a2r * a1r - a2i * a1i
    ai = a2r * a1i + a2i * a1r
    br = a2r * b1r - a2i * b1i + b2r
    bi = a2r * b1i + a2i * b1r + b2i
    return ar, ai, br, bi


def s5_mixer(u, a_re, a_im, log_dt, b_re, b_im, c_re, c_im, d, w_glu, b_glu):
    f32 = jnp.float32
    bsz, seq, _ = u.shape
    uf = u.astype(f32).reshape(bsz, seq, S5_GROUPS, S5_GROUP)
    a_re = a_re.astype(f32)
    a_im = a_im.astype(f32)
    dt = jnp.exp(log_dt.astype(f32))[:, None]
    mag = jnp.exp(dt * a_re)
    abar_re = mag * jnp.cos(dt * a_im)
    abar_im = mag * jnp.sin(dt * a_im)
    den = a_re * a_re + a_im * a_im
    q_re = ((abar_re - 1.0) * a_re + abar_im * a_im) / den
    q_im = (abar_im * a_re - (abar_re - 1.0) * a_im) / den
    b_re = b_re.astype(f32)
    b_im = b_im.astype(f32)
    bbar_re = q_re[..., None] * b_re - q_im[..., None] * b_im
    bbar_im = q_re[..., None] * b_im + q_im[..., None] * b_re
    bu_re = jnp.einsum('bsgh,gph->bsgp', uf, bbar_re)
    bu_im = jnp.einsum('bsgh,gph->bsgp', uf, bbar_im)
    lam_re = jnp.broadcast_to(abar_re, (1, seq) + abar_re.shape)
    lam_im = jnp.broadcast_to(abar_im, (1, seq) + abar_im.shape)
    _, _, h_re, h_im = lax.associative_scan(
        _complex_diag_combine, (lam_re, lam_im, bu_re, bu_im), axis=1)
    y = (jnp.einsum('bsgp,ghp->bsgh', h_re, c_re.astype(f32))
         - jnp.einsum('bsgp,ghp->bsgh', h_im, c_im.astype(f32)))
    y = y + d.astype(f32) * uf
    y = jax.nn.gelu(y.reshape(bsz, seq, D_S5))
    y = y * jax.nn.sigmoid(y @ w_glu.astype(f32) + b_glu.astype(f32))
    return y.astype(u.dtype)


def causal_depthwise_conv(x, w, b):
    seq = x.shape[1]
    xp = jnp.pad(x, ((0, 0), (CONV_WIDTH - 1, 0), (0, 0)))
    out = b
    for k in range(CONV_WIDTH):
        out = out + xp[:, k:k + seq] * w[k]
    return out


def _linear_recurrence_combine(left, right):
    a1, b1 = left
    a2, b2 = right
    return a1 * a2, a2 * b1 + b2


def rglru_mixer(xb, gate, conv_w, conv_b, w_a, b_a, w_x, b_x, lam):
    f32 = jnp.float32
    bsz, seq, _ = xb.shape
    xc = causal_depthwise_conv(xb.astype(f32), conv_w.astype(f32), conv_b.astype(f32))
    xh = xc.reshape(bsz, seq, LRU_HEADS, LRU_HEAD_DIM)
    r = jax.nn.sigmoid(jnp.einsum('bshi,hij->bshj', xh, w_a.astype(f32)) + b_a.astype(f32))
    ig = jax.nn.sigmoid(jnp.einsum('bshi,hij->bshj', xh, w_x.astype(f32)) + b_x.astype(f32))
    r = r.reshape(bsz, seq, D_LRU)
    ig = ig.reshape(bsz, seq, D_LRU)
    log_a = -LRU_C * r * jax.nn.softplus(-lam.astype(f32))
    a = jnp.exp(log_a)
    mult = jnp.sqrt(-jnp.expm1(2.0 * log_a))
    _, h = lax.associative_scan(_linear_recurrence_combine, (a, mult * (ig * xc)), axis=1)
    y = h * jax.nn.gelu(gate.astype(f32))
    return y.astype(xb.dtype)


def memory_cross_attention(h, mem_n, w_q, w_k, w_v, w_o):
    bsz, seq, _ = h.shape
    mlen = mem_n.shape[1]
    q = (h @ w_q).reshape(bsz, seq, CA_HEADS, CA_HEAD_DIM)
    k = (mem_n @ w_k).reshape(bsz, mlen, CA_HEADS, CA_HEAD_DIM)
    v = (mem_n @ w_v).reshape(bsz, mlen, CA_HEADS, CA_HEAD_DIM)
    scores = jnp.einsum('bshd,bmhd->bhsm', q.astype(jnp.float32), k.astype(jnp.float32))
    probs = jax.nn.softmax(scores * (CA_HEAD_DIM ** -0.5), axis=-1)
    out = jnp.einsum('bhsm,bmhd->bshd', probs, v.astype(jnp.float32))
    out = out.reshape(bsz, seq, D_MODEL).astype(h.dtype)
    return out @ w_o


def setup_inputs(seed: int = 0) -> dict:
    key = jax.random.key(seed)
    ks = iter(jax.random.split(key, 48))
    nrm = lambda shape, s: s * jax.random.normal(next(ks), shape, jnp.float32)
    L = DEPTH
    x = jax.random.normal(next(ks), (BATCH, SEQ, D_MODEL), jnp.float32)
    mem = jax.random.normal(next(ks), (BATCH, MEM_LEN, D_MODEL), jnp.float32)
    n = jnp.arange(S5_STATE, dtype=jnp.float32)
    s5_a_re = -0.5 + nrm((L, S5_GROUPS, S5_STATE), 0.01)
    s5_a_im = jnp.pi * n + nrm((L, S5_GROUPS, S5_STATE), 0.01)
    s5_log_dt = jax.random.uniform(next(ks), (L, S5_GROUPS), jnp.float32,
                                   math.log(1e-3), math.log(1e-1))
    u_a = jax.random.uniform(next(ks), (L, D_LRU), jnp.float32, 0.9, 0.999)
    a0 = u_a ** (1.0 / LRU_C)
    lru_lambda = jnp.log(a0) - jnp.log1p(-a0)
    return {
        "x": x,
        "mem": mem,
        "ln_in_g": 1.0 + nrm((D_MODEL,), 0.02),
        "ln_in_b": nrm((D_MODEL,), 0.02),
        "w_in": nrm((L, D_MODEL, D_IN), D_MODEL ** -0.5),
        "s5_a_re": s5_a_re,
        "s5_a_im": s5_a_im,
        "s5_log_dt": s5_log_dt,
        "s5_b_re": nrm((L, S5_GROUPS, S5_STATE, S5_GROUP), (2.0 * S5_GROUP) ** -0.5),
        "s5_b_im": nrm((L, S5_GROUPS, S5_STATE, S5_GROUP), (2.0 * S5_GROUP) ** -0.5),
        "s5_c_re": nrm((L, S5_GROUPS, S5_GROUP, S5_STATE), (2.0 * S5_STATE) ** -0.5),
        "s5_c_im": nrm((L, S5_GROUPS, S5_GROUP, S5_STATE), (2.0 * S5_STATE) ** -0.5),
        "s5_d": nrm((L, S5_GROUPS, S5_GROUP), 1.0),
        "s5_w_glu": nrm((L, D_S5, D_S5), D_S5 ** -0.5),
        "s5_b_glu": nrm((L, D_S5), 0.02),
        "conv_w": nrm((L, CONV_WIDTH, D_LRU), CONV_WIDTH ** -0.5),
        "conv_b": nrm((L, D_LRU), 0.02),
        "lru_w_a": nrm((L, LRU_HEADS, LRU_HEAD_DIM, LRU_HEAD_DIM), LRU_HEAD_DIM ** -0.5),
        "lru_b_a": nrm((L, LRU_HEADS, LRU_HEAD_DIM), 0.02),
        "lru_w_x": nrm((L, LRU_HEADS, LRU_HEAD_DIM, LRU_HEAD_DIM), LRU_HEAD_DIM ** -0.5),
        "lru_b_x": nrm((L, LRU_HEADS, LRU_HEAD_DIM), 0.02),
        "lru_lambda": lru_lambda,
        "g_s5": 1.0 + nrm((L, D_S5), 0.02),
        "g_lru": 1.0 + nrm((L, D_LRU), 0.02),
        "w_mix_out": nrm((L, D_MODEL, D_MODEL), BETA * D_MODEL ** -0.5),
        "ln1_g": 1.0 + nrm((L, D_MODEL), 0.02),
        "ln1_b": nrm((L, D_MODEL), 0.02),
        "mem_ln_g": 1.0 + nrm((L, D_MODEL), 0.02),
        "mem_ln_b": nrm((L, D_MODEL), 0.02),
        "w_q": nrm((L, D_MODEL, D_MODEL), D_MODEL ** -0.5),
        "w_k": nrm((L, D_MODEL, D_MODEL), D_MODEL ** -0.5),
        "w_v": nrm((L, D_MODEL, D_MODEL), BETA * D_MODEL ** -0.5),
        "w_o": nrm((L, D_MODEL, D_MODEL), BETA * D_MODEL ** -0.5),
        "ln2_g": 1.0 + nrm((L, D_MODEL), 0.02),
        "ln2_b": nrm((L, D_MODEL), 0.02),
        "w_ff1": nrm((L, D_MODEL, D_FF), BETA * D_MODEL ** -0.5),
        "w_ff2": nrm((L, D_FF, D_MODEL), BETA * D_FF ** -0.5),
        "ln3_g": 1.0 + nrm((L, D_MODEL), 0.02),
        "ln3_b": nrm((L, D_MODEL), 0.02),
    }


def reference(x, mem, ln_in_g, ln_in_b, w_in, s5_a_re, s5_a_im, s5_log_dt, s5_b_re, s5_b_im,
              s5_c_re, s5_c_im, s5_d, s5_w_glu, s5_b_glu, conv_w, conv_b, lru_w_a, lru_b_a,
              lru_w_x, lru_b_x, lru_lambda, g_s5, g_lru, w_mix_out, ln1_g, ln1_b,
              mem_ln_g, mem_ln_b, w_q, w_k, w_v, w_o, ln2_g, ln2_b, w_ff1, w_ff2,
              ln3_g, ln3_b):
    h = layer_norm(x, ln_in_g, ln_in_b)
    for l in range(DEPTH):
        z = h @ w_in[l]
        u_s5 = z[..., :D_S5]
        x_lru = z[..., D_S5:D_S5 + D_LRU]
        gate_lru = z[..., D_S5 + D_LRU:]
        y_s5 = s5_mixer(u_s5, s5_a_re[l], s5_a_im[l], s5_log_dt[l], s5_b_re[l], s5_b_im[l],
                        s5_c_re[l], s5_c_im[l], s5_d[l], s5_w_glu[l], s5_b_glu[l])
        y_lru = rglru_mixer(x_lru, gate_lru, conv_w[l], conv_b[l], lru_w_a[l], lru_b_a[l],
                            lru_w_x[l], lru_b_x[l], lru_lambda[l])
        y = jnp.concatenate([rms_norm(y_s5, g_s5[l]), rms_norm(y_lru, g_lru[l])], axis=-1)
        h = layer_norm(ALPHA * h + y @ w_mix_out[l], ln1_g[l], ln1_b[l])
        mem_n = layer_norm(mem, mem_ln_g[l], mem_ln_b[l])
        ca = memory_cross_attention(h, mem_n, w_q[l], w_k[l], w_v[l], w_o[l])
        h = layer_norm(ALPHA * h + ca, ln2_g[l], ln2_b[l])
        ff = jnp.square(jax.nn.relu(h @ w_ff1[l])) @ w_ff2[l]
        h = layer_norm(ALPHA * h + ff, ln3_g[l], ln3_b[l])
    return h
```

```cpp
#include <hip/hip_runtime.h>
namespace nv {
constexpr int D = 1024, S = 2048, DIN = 1536, DS5 = 512, DLRU = 512, DFF = 4096, MEM = 256;
constexpr float ALPHA = 1.189207115002721f;

__device__ __forceinline__ float gelu_tanh(float x) {
    const float k = 0.7978845608028654f;
    float u = k * (x + 0.044715f * x * x * x);
    return 0.5f * x * (1.0f + tanhf(u));
}
__device__ __forceinline__ float sigmoidf_(float x) { return 1.0f / (1.0f + expf(-x)); }

__device__ __forceinline__ float block_sum256(float v, float* red) {
    for (int o = 32; o > 0; o >>= 1) v += __shfl_xor(v, o);
    __syncthreads();
    if ((threadIdx.x & 63) == 0) red[threadIdx.x >> 6] = v;
    __syncthreads();
    return red[0] + red[1] + red[2] + red[3];
}

__global__ void __launch_bounds__(256) k_add_ln(const float* a, const float* c, float alpha, const float* g, const float* b, float* out) {
    __shared__ float red[4];
    size_t row = blockIdx.x; float v[4];
    for (int j = 0; j < 4; ++j) { int i = threadIdx.x + 256 * j; float t = 0.f; if (a) t += alpha * a[row * D + i]; if (c) t += c[row * D + i]; v[j] = t; }
    float mu = block_sum256(v[0] + v[1] + v[2] + v[3], red) * (1.0f / D);
    float q = 0.f; for (int j = 0; j < 4; ++j) { float d = v[j] - mu; q += d * d; }
    float var = block_sum256(q, red) * (1.0f / D);
    float rstd = rsqrtf(var + 1e-5f);
    for (int j = 0; j < 4; ++j) { int i = threadIdx.x + 256 * j; out[row * D + i] = (v[j] - mu) * rstd * g[i] + b[i]; }
}
__global__ void __launch_bounds__(256) k_rms512(const float* x, const float* g, float* out, int ldo) {
    __shared__ float red[4];
    size_t row = blockIdx.x; float v0 = x[row * 512 + threadIdx.x], v1 = x[row * 512 + 256 + threadIdx.x];
    float ms = block_sum256(v0 * v0 + v1 * v1, red) * (1.0f / 512);
    float r = rsqrtf(ms + 1e-6f);
    out[row * ldo + threadIdx.x] = v0 * r * g[threadIdx.x]; out[row * ldo + 256 + threadIdx.x] = v1 * r * g[256 + threadIdx.x];
}
__global__ void __launch_bounds__(256) k_gemm(const float* A, int lda, const float* W, int ldw, float* C, int ldc, int K) {
    __shared__ float As[16][64 + 4], Ws[16][64 + 4];
    const int tx = threadIdx.x & 15, ty = threadIdx.x >> 4;
    const size_t m0 = (size_t)blockIdx.y * 64, n0 = (size_t)blockIdx.x * 64;
    float acc[4][4] = {};
    for (int k0 = 0; k0 < K; k0 += 16) {
        for (int i = threadIdx.x; i < 64 * 16; i += 256) { int r = i >> 4, c = i & 15; As[c][r] = A[(m0 + r) * lda + k0 + c]; }
        for (int i = threadIdx.x; i < 64 * 16; i += 256) { int r = i >> 6, c = i & 63; Ws[r][c] = W[(size_t)(k0 + r) * ldw + n0 + c]; }
        __syncthreads();
#pragma unroll
        for (int k = 0; k < 16; ++k) {
            float a[4], w[4];
#pragma unroll
            for (int i = 0; i < 4; ++i) { a[i] = As[k][ty * 4 + i]; w[i] = Ws[k][tx * 4 + i]; }
#pragma unroll
            for (int i = 0; i < 4; ++i)
#pragma unroll
                for (int j = 0; j < 4; ++j) acc[i][j] += a[i] * w[j];
        }
        __syncthreads();
    }
#pragma unroll
    for (int i = 0; i < 4; ++i)
#pragma unroll
        for (int j = 0; j < 4; ++j) C[(m0 + ty * 4 + i) * ldc + n0 + tx * 4 + j] = acc[i][j];
}
__global__ void __launch_bounds__(64) k_s5(const float* z, const float* a_re, const float* a_im, const float* log_dt, const float* b_re, const float* b_im,
                                           const float* c_re, const float* c_im, const float* dd, float* y) {
    __shared__ float red[16][65];
    const int g = blockIdx.x & 31, bl = blockIdx.x >> 5, p = threadIdx.x;
    const float dt = expf(log_dt[g]); const float ar = a_re[g * 64 + p], ai = a_im[g * 64 + p];
    const float mag = expf(dt * ar); const float lr = mag * cosf(dt * ai), li = mag * sinf(dt * ai);
    const float den = ar * ar + ai * ai; const float qr = ((lr - 1.f) * ar + li * ai) / den, qi = (li * ar - (lr - 1.f) * ai) / den;
    float Br[16], Bi[16], Cr[16], Ci[16];
#pragma unroll
    for (int h = 0; h < 16; ++h) { float br = b_re[(g * 64 + p) * 16 + h], bi = b_im[(g * 64 + p) * 16 + h]; Br[h] = qr * br - qi * bi; Bi[h] = qr * bi + qi * br;
        Cr[h] = c_re[(g * 16 + h) * 64 + p]; Ci[h] = c_im[(g * 16 + h) * 64 + p]; }
    float hr = 0.f, hi = 0.f;
    for (int t = 0; t < S; ++t) {
        const float* zr = z + ((size_t)bl * S + t) * DIN + g * 16;
        float ur = 0.f, ui = 0.f;
#pragma unroll
        for (int h = 0; h < 16; ++h) { float uu = zr[h]; ur += Br[h] * uu; ui += Bi[h] * uu; }
        float nr = lr * hr - li * hi + ur, ni = lr * hi + li * hr + ui; hr = nr; hi = ni;
#pragma unroll
        for (int h = 0; h < 16; ++h) red[h][p] = Cr[h] * hr - Ci[h] * hi;
        __syncthreads();
        { int ho = p >> 2, q4 = p & 3; float s = 0.f; for (int j = 0; j < 16; ++j) s += red[ho][q4 * 16 + j];
          s += __shfl_xor(s, 1); s += __shfl_xor(s, 2);
          if (q4 == 0) y[((size_t)bl * S + t) * 512 + g * 16 + ho] = s + dd[g * 16 + ho] * zr[ho]; }
        __syncthreads();
    }
}
__global__ void k_conv(const float* z, const float* cw, const float* cb, float* xc, int T) {
    size_t i = (size_t)blockIdx.x * blockDim.x + threadIdx.x; if (i >= (size_t)T * 512) return;
    int c = i & 511; size_t t = i >> 9; int ts = (int)(t % S);
    float v = cb[c];
    for (int k = 0; k < 4; ++k) { int tt = ts - 3 + k; if (tt >= 0) v += cw[k * 512 + c] * z[(t - 3 + k) * DIN + 512 + c]; }
    xc[i] = v;
}
__global__ void k_lru_ab(float* pa, float* px, const float* xc, const float* ba, const float* bx, const float* lam, int T) {
    size_t i = (size_t)blockIdx.x * blockDim.x + threadIdx.x; if (i >= (size_t)T * 512) return;
    int c = i & 511;
    float r = sigmoidf_(pa[i] + ba[c]), ig = sigmoidf_(px[i] + bx[c]);
    float sp = log1pf(expf(-lam[c]));
    float la = -8.0f * r * sp; float a = expf(la); float mult = sqrtf(-expm1f(2.0f * la));
    pa[i] = a; px[i] = mult * (ig * xc[i]);
}
__global__ void k_lru_scan(const float* a, const float* b, const float* z, float* y, int nb) {
    int i = blockIdx.x * blockDim.x + threadIdx.x; if (i >= nb * 512) return;
    int c = i & 511, bl = i >> 9; float h = 0.f;
    for (int t = 0; t < S; ++t) { size_t r = (size_t)bl * S + t; h = a[r * 512 + c] * h + b[r * 512 + c]; y[r * 512 + c] = h * gelu_tanh(z[r * DIN + 1024 + c]); }
}
__global__ void k_gelu_inplace(float* x, size_t n) { size_t i = (size_t)blockIdx.x * blockDim.x + threadIdx.x; if (i < n) x[i] = gelu_tanh(x[i]); }
__global__ void k_glu(const float* ys, float* glu, const float* bg, size_t n) { size_t i = (size_t)blockIdx.x * blockDim.x + threadIdx.x; if (i < n) glu[i] = ys[i] * sigmoidf_(glu[i] + bg[i & 511]); }
__global__ void k_relu2(float* x, size_t n) { size_t i = (size_t)blockIdx.x * blockDim.x + threadIdx.x; if (i < n) { float v = fmaxf(x[i], 0.f); x[i] = v * v; } }
__global__ void __launch_bounds__(256) k_attn(const float* q, const float* Km, const float* Vm, float* ao) {
    __shared__ float qs[256], ps[256], red[4];
    const int h = blockIdx.x & 3; const size_t t = blockIdx.x >> 2; const int bl = (int)(t / S);
    qs[threadIdx.x] = q[t * D + h * 256 + threadIdx.x];
    __syncthreads();
    const float* kr = Km + ((size_t)bl * MEM + threadIdx.x) * D + h * 256;
    float s = 0.f; for (int d = 0; d < 256; ++d) s += qs[d] * kr[d];
    s *= 0.0625f;
    float m = s; for (int o = 32; o > 0; o >>= 1) m = fmaxf(m, __shfl_xor(m, o));
    if ((threadIdx.x & 63) == 0) red[threadIdx.x >> 6] = m;
    __syncthreads();
    m = fmaxf(fmaxf(red[0], red[1]), fmaxf(red[2], red[3]));
    float e = expf(s - m);
    float sum = block_sum256(e, red);
    ps[threadIdx.x] = e / sum;
    __syncthreads();
    const float* vc = Vm + ((size_t)bl * MEM) * D + h * 256 + threadIdx.x;
    float o = 0.f; for (int mm = 0; mm < 256; ++mm) o += ps[mm] * vc[(size_t)mm * D];
    ao[t * D + h * 256 + threadIdx.x] = o;
}

struct NaiveBufs { float *h0, *big, *ycat, *tmp, *h1, *q, *ao, *h2, *memn, *Km, *Vm; };
inline size_t naive_floats(int nb) { size_t T = (size_t)nb * S; return T * (1024 + 4608 + 1024 * 6) + (size_t)nb * MEM * 1024 * 3; }

inline NaiveBufs run_naive(void* const* d_in, float* out_rows, float* ws, hipStream_t st, int b0, int nb, int stop_stage = 99) {
    auto in = [&](int i) { return (const float*)d_in[i]; };
    const int T = nb * S; NaiveBufs B;
    float* p = ws;
    B.h0 = p; p += (size_t)T * 1024; B.big = p; p += (size_t)T * 4608; B.ycat = p; p += (size_t)T * 1024; B.tmp = p; p += (size_t)T * 1024;
    B.h1 = p; p += (size_t)T * 1024; B.q = p; p += (size_t)T * 1024; B.ao = p; p += (size_t)T * 1024; B.h2 = p; p += (size_t)T * 1024;
    B.memn = p; p += (size_t)nb * MEM * 1024; B.Km = p; p += (size_t)nb * MEM * 1024; B.Vm = p; p += (size_t)nb * MEM * 1024;
    float* z = B.big; float* xc = z + (size_t)T * 1536; float* pa = xc + (size_t)T * 512; float* px = pa + (size_t)T * 512;
    float* ylru = px + (size_t)T * 512; float* ys = ylru + (size_t)T * 512; float* glu = ys + (size_t)T * 512; float* f1 = B.big;
    const float* x = in(0) + (size_t)b0 * S * D; const float* mem = in(1) + (size_t)b0 * MEM * D;
    auto gemm = [&](const float* A, int lda, const float* W, int ldw, float* C, int ldc, int M, int N, int K) {
        hipLaunchKernelGGL(k_gemm, dim3(N / 64, M / 64), dim3(256), 0, st, A, lda, W, ldw, C, ldc, K); };
    const int EB = 256; auto eg = [&](size_t n) { return dim3((unsigned)((n + EB - 1) / EB)); };
    hipLaunchKernelGGL(k_add_ln, dim3(T), dim3(256), 0, st, (const float*)nullptr, x, 0.f, in(2), in(3), B.h0);
    if (stop_stage == 0) return B;
    gemm(B.h0, 1024, in(4), 1536, z, 1536, T, 1536, 1024);
    if (stop_stage == 1) return B;
    hipLaunchKernelGGL(k_s5, dim3(nb * 32), dim3(64), 0, st, z, in(5), in(6), in(7), in(8), in(9), in(10), in(11), in(12), ys);
    hipLaunchKernelGGL(k_conv, eg((size_t)T * 512), dim3(EB), 0, st, z, in(15), in(16), xc, T);
    for (int h = 0; h < 8; ++h) {
        gemm(xc + h * 64, 512, in(17) + h * 4096, 64, pa + h * 64, 512, T, 64, 64);
        gemm(xc + h * 64, 512, in(19) + h * 4096, 64, px + h * 64, 512, T, 64, 64);
    }
    hipLaunchKernelGGL(k_lru_ab, eg((size_t)T * 512), dim3(EB), 0, st, pa, px, xc, in(18), in(20), in(21), T);
    if (stop_stage == 2) return B;
    hipLaunchKernelGGL(k_lru_scan, dim3((nb * 512 + 63) / 64), dim3(64), 0, st, pa, px, z, ylru, nb);
    hipLaunchKernelGGL(k_gelu_inplace, eg((size_t)T * 512), dim3(EB), 0, st, ys, (size_t)T * 512);
    if (stop_stage == 3) return B;
    gemm(ys, 512, in(13), 512, glu, 512, T, 512, 512);
    hipLaunchKernelGGL(k_glu, eg((size_t)T * 512), dim3(EB), 0, st, ys, glu, in(14), (size_t)T * 512);
    hipLaunchKernelGGL(k_rms512, dim3(T), dim3(256), 0, st, glu, in(22), B.ycat, 1024);
    hipLaunchKernelGGL(k_rms512, dim3(T), dim3(256), 0, st, ylru, in(23), B.ycat + 512, 1024);
    if (stop_stage == 4) return B;
    gemm(B.ycat, 1024, in(24), 1024, B.tmp, 1024, T, 1024, 1024);
    hipLaunchKernelGGL(k_add_ln, dim3(T), dim3(256), 0, st, B.h0, B.tmp, ALPHA, in(25), in(26), B.h1);
    if (stop_stage == 5) return B;
    hipLaunchKernelGGL(k_add_ln, dim3(nb * MEM), dim3(256), 0, st, (const float*)nullptr, mem, 0.f, in(27), in(28), B.memn);
    gemm(B.memn, 1024, in(30), 1024, B.Km, 1024, nb * MEM, 1024, 1024);
    gemm(B.memn, 1024, in(31), 1024, B.Vm, 1024, nb * MEM, 1024, 1024);
    gemm(B.h1, 1024, in(29), 1024, B.q, 1024, T, 1024, 1024);
    if (stop_stage == 6) return B;
    hipLaunchKernelGGL(k_attn, dim3(T * 4), dim3(256), 0, st, B.q, B.Km, B.Vm, B.ao);
    if (stop_stage == 7) return B;
    gemm(B.ao, 1024, in(32), 1024, B.tmp, 1024, T, 1024, 1024);
    hipLaunchKernelGGL(k_add_ln, dim3(T), dim3(256), 0, st, B.h1, B.tmp, ALPHA, in(33), in(34), B.h2);
    if (stop_stage == 8) return B;
    gemm(B.h2, 1024, in(35), 4096, f1, 4096, T, 4096, 1024);
    hipLaunchKernelGGL(k_relu2, eg((size_t)T * 4096), dim3(EB), 0, st, f1, (size_t)T * 4096);
    if (stop_stage == 9) return B;
    gemm(f1, 4096, in(36), 1024, B.tmp, 1024, T, 1024, 4096);
    hipLaunchKernelGGL(k_add_ln, dim3(T), dim3(256), 0, st, B.h2, B.tmp, ALPHA, in(37), in(38), out_rows);
    return B;
}
}
extern "C" void kernel_launch(void* const* d_in, const int* in_sizes, int n_in, void* d_out, int out_size, void* d_ws, size_t ws_size, hipStream_t stream) {
    (void)in_sizes; (void)n_in; (void)out_size; (void)ws_size;
    for (int b0 = 0; b0 < 16; b0 += 4)
        nv::run_naive(d_in, (float*)d_out + (size_t)b0 * nv::S * nv::D, (float*)d_ws, stream, b0, 4);
}
```

```cpp
#include <hip/hip_runtime.h>
#include <cstdio>
#define MK_MULTI 0
#define MK_DEBUG 0
#include <hip/hip_cooperative_groups.h>
namespace cg = cooperative_groups;
namespace fp {
#define LAS __attribute__((address_space(3)))
typedef unsigned short bf16_t;
typedef short bf16x8 __attribute__((ext_vector_type(8)));
typedef float f32x4 __attribute__((ext_vector_type(4)));
typedef float f32x2 __attribute__((ext_vector_type(2)));
typedef unsigned u32x4 __attribute__((ext_vector_type(4)));
typedef unsigned u32x2 __attribute__((ext_vector_type(2)));

constexpr int D = 1024, S = 2048, B = 16, M = B * S, DIN = 1536, DFF = 4096, MEM = 256, NG = 32, CH = 32  , NCH = S / CH  ;
constexpr float ALPHA = 1.189207115002721f;
constexpr int NTHREADS = 512;

constexpr size_t MiB = 1u << 20, KiB = 1u << 10;
constexpr size_t WS_STATS0 = 64 * KiB;
constexpr size_t WS_SSQ = 320 * KiB;
constexpr size_t WS_STATS1 = 448 * KiB;
constexpr size_t WS_STATS2 = 704 * KiB;
constexpr size_t WS_STATS3 = 960 * KiB;
constexpr size_t WS_ZERO_BEG = WS_SSQ, WS_ZERO_END = 1216 * KiB;
constexpr size_t WS_C1Q = 1216 * KiB, WS_C2Q = WS_C1Q + 4096, WS_C1F = WS_C2Q + 4096, WS_C2F = WS_C1F + 16384;
constexpr size_t WS_GBIAS = 1256 * KiB;
constexpr size_t WS_SP8 = 1260 * KiB;
constexpr size_t WS_LAML = 1264 * KiB;
constexpr size_t WS_DBG = 1300 * KiB;
constexpr size_t WS_WIN = 4 * MiB;
constexpr size_t WS_WGLU = 7 * MiB;
constexpr size_t WS_WMIX = WS_WGLU + MiB / 2;
constexpr size_t WS_WQ = WS_WMIX + 2 * MiB, WS_WK = WS_WQ + 2 * MiB, WS_WV = WS_WK + 2 * MiB, WS_WO = WS_WV + 2 * MiB;
constexpr size_t WS_WF1 = WS_WO + 2 * MiB;
constexpr size_t WS_WF2 = WS_WF1 + 8 * MiB;
constexpr size_t WS_S5T = 34 * MiB + MiB / 2;
constexpr size_t WS_S5P = WS_S5T + 20 * MiB;
constexpr size_t WS_GATES = WS_S5P + 8 * MiB;
constexpr size_t WS_V1B = 64 * MiB;
constexpr size_t WS_YCAT = 128 * MiB;
constexpr size_t WS_PROB = 128 * MiB;
constexpr size_t WS_V2 = 128 * MiB;
constexpr size_t WS_KMAT = 192 * MiB;
constexpr size_t WS_VT = 200 * MiB;
constexpr size_t WS_Y1 = 208 * MiB;
constexpr size_t WS_U = 256 * MiB;
constexpr size_t WS_XL = 296 * MiB;
constexpr size_t WS_GG = 330 * MiB;
constexpr size_t WS_XEND = 362 * MiB;
constexpr size_t WS_AGG = 378 * MiB;
constexpr size_t WS_V1 = 256 * MiB;
constexpr size_t WS_H0B = 384 * MiB;
constexpr size_t WS_LA = 384 * MiB;
constexpr size_t WS_AO = 384 * MiB;
constexpr size_t WS_MEMN = 448 * MiB;
constexpr size_t WS_LB = 448 * MiB;
constexpr size_t WS_Q = 448 * MiB;
constexpr size_t WS_HDN = 256 * MiB;
constexpr size_t WS_END = 512 * MiB;
constexpr int XLROWS = S + 3;

constexpr int LDS_STAGE = 131072, LDS_X = LDS_STAGE  , LDS_BYTES = 147456;

__device__ __forceinline__ unsigned cvt_pk_bf16(float lo, float hi) { unsigned r; asm volatile("v_cvt_pk_bf16_f32 %0, %1, %2" : "=v"(r) : "v"(lo), "v"(hi)); return r; }
__device__ __forceinline__ bf16_t f2bf(float f) { return (bf16_t)(cvt_pk_bf16(f, 0.f) & 0xffffu); }
__device__ __forceinline__ float bf2f(unsigned short b) { return __uint_as_float(((unsigned)b) << 16); }
__device__ __forceinline__ float bflo(unsigned w) { return __uint_as_float(w << 16); }
__device__ __forceinline__ float bfhi(unsigned w) { return __uint_as_float(w & 0xffff0000u); }
__device__ __forceinline__ u32x4 pack8(f32x4 a, f32x4 b) { u32x4 w; w.x = cvt_pk_bf16(a[0], a[1]); w.y = cvt_pk_bf16(a[2], a[3]); w.z = cvt_pk_bf16(b[0], b[1]); w.w = cvt_pk_bf16(b[2], b[3]); return w; }
__device__ __forceinline__ void unpack8(u32x4 w, f32x4& a, f32x4& b) { a[0] = bflo(w.x); a[1] = bfhi(w.x); a[2] = bflo(w.y); a[3] = bfhi(w.y); b[0] = bflo(w.z); b[1] = bfhi(w.z); b[2] = bflo(w.w); b[3] = bfhi(w.w); }
__device__ __forceinline__ float fast_exp(float x) { return __builtin_amdgcn_exp2f(x * 1.4426950408889634f); }
__device__ __forceinline__ float fast_rcp(float x) { return __builtin_amdgcn_rcpf(x); }
__device__ __forceinline__ float sigm(float x) { return fast_rcp(1.0f + fast_exp(-x)); }
__device__ __forceinline__ float gelu_t(float x) {
    const float u = 0.7978845608028654f * (x + 0.044715f * x * x * x);
    return x * sigm(2.0f * u);
}
__device__ __forceinline__ float wave_sum(float v) {
#pragma unroll
    for (int o = 32; o > 0; o >>= 1) v += __shfl_xor(v, o);
    return v;
}

constexpr int BM = 256, BK = 64, HALF = 128, HTB = HALF * BK * 2, NXCD = 8, WGM = 8;
__device__ __forceinline__ int lds_byte(int r, int c) { const int st = (r >> 4) * 2 + (c >> 5), rr = r & 15, cc = c & 31, ob = rr * 64 + cc * 2; return st * 1024 + (ob ^ (((ob >> 9) & 1) << 5)); }
__device__ __forceinline__ void stage_rc(int b, int& R, int& C) { const int st = b / 1024, sb = b % 1024, swz = sb ^ (((sb >> 9) & 1) << 5); R = (st >> 1) * 16 + swz / 64; C = (st & 1) * 32 + (swz % 64) / 2; }
__device__ __forceinline__ int perm32(int rho) { const int n = rho >> 4, i = rho & 15; return 8 * (i >> 2) + 4 * n + (i & 3); }

struct Unit { int pm, pn, pb; };
template <int LDA, int LDB, int NT, int NM, int NN, int NB, long SAM, long SAB0, long SAB1, int BDIV, long SBN, long SBB0, long SBB1, int CONV>
struct GeomT {
    const bf16_t* A; const bf16_t* Bt;
    static constexpr int lda = LDA, ldb = LDB, nt = NT;
    static constexpr int nwg = NM * NN * NB;
    __device__ __forceinline__ bool next(int i, int G, int c, Unit& u) const {
        const int L = i * G + c; if (L >= nwg) return false;
        int wgid = L; { constexpr int q = nwg / NXCD, r = nwg % NXCD; const int xcd = wgid % NXCD, off = wgid / NXCD; wgid = (xcd < r ? xcd * (q + 1) : r * (q + 1) + (xcd - r) * q) + off; }
        constexpr int per = NM * NN; u.pb = wgid / per; const int w = wgid % per;
        constexpr int nig = WGM * NN; const int gid = w / nig, fm = gid * WGM, gsz = (NM - fm) < WGM ? (NM - fm) : WGM;
        u.pm = fm + ((w % nig) % gsz); u.pn = (w % nig) / gsz; return true;
    }
    __device__ __forceinline__ const char* abase(const Unit& u) const { return (const char*)(A + (long)u.pm * SAM + (long)(u.pb / BDIV) * SAB0 + (long)(u.pb % BDIV) * SAB1); }
    __device__ __forceinline__ const char* bbase(const Unit& u) const { return (const char*)(Bt + (long)u.pn * SBN + (long)(u.pb / BDIV) * SBB0 + (long)(u.pb % BDIV) * SBB1); }
    static __device__ __forceinline__ size_t koffA(int t) { return CONV ? ((size_t)(t >> 1) * (size_t)LDA * 2 + (size_t)(t & 1) * 128) : (size_t)t * 128; }
    static __device__ __forceinline__ size_t koffB(int t) { return (size_t)t * 128; }
};
template <int LDA, int LDB, int Mr, int Nc, int K> using PlainGeom = GeomT<LDA, LDB, K / 64, Mr / 256, Nc / 256, 1, 256L * LDA, 0, 0, 1, 256L * LDB, 0, 0, 0>;

template <class Geom, class Epi>
__device__ __forceinline__ void gemm_phase(LAS unsigned char* lds, const Geom g, const Epi& E, const int G, const int c) {
    const int tid = threadIdx.x, wid = __builtin_amdgcn_readfirstlane(tid >> 6), lane = tid & 63, wr = wid >> 2, wc = wid & 3, fr = lane & 15, fq = lane >> 4;
    constexpr int nt = Geom::nt;
    unsigned voffA[2], voffB[2];
#pragma unroll
    for (int i = 0; i < 2; ++i) { int R, C; stage_rc(tid * 16 + i * 8192, R, C); const int Rb = (R & ~31) + perm32(R & 31);
        voffA[i] = (unsigned)(R * Geom::lda + C) * 2u; voffB[i] = (unsigned)(Rb * Geom::ldb + C) * 2u; }
    constexpr size_t hstepA = (size_t)HALF * Geom::lda * 2, hstepB = (size_t)HALF * Geom::ldb * 2;
    const unsigned ldsw = (unsigned)wid * 1024u;
    const int aoff = lds_byte(wr * 64 + fr, fq * 8), boff = lds_byte(wc * 32 + fr, fq * 8);
#define PG8_SA(b, h) (((b) * 2 + (h)) * HTB)
#define PG8_SB(b, h) ((4 + (b) * 2 + (h)) * HTB)
#define PG8_STAGE(bufoff, gbase, voff) do { _Pragma("unroll") for (int _i = 0; _i < 2; ++_i) \
        __builtin_amdgcn_global_load_lds((const unsigned*)((const char*)(gbase) + (voff)[_i]), (LAS unsigned*)(lds + (bufoff) + ldsw + _i * 8192), 16, 0, 0); } while (0)
#define PG8_LDA(dst, b, h) do { _Pragma("unroll") for (int m = 0; m < 4; ++m) _Pragma("unroll") for (int k = 0; k < 2; ++k) dst[m][k] = *(const LAS bf16x8*)(lds + PG8_SA(b, h) + aoff + m * 2048 + k * 1024); } while (0)
#define PG8_LDB(dst, b, h) do { _Pragma("unroll") for (int n = 0; n < 2; ++n) _Pragma("unroll") for (int k = 0; k < 2; ++k) dst[n][k] = *(const LAS bf16x8*)(lds + PG8_SB(b, h) + boff + n * 2048 + k * 1024); } while (0)
#define PG8_MMA(ai, bj, At, Bt) do { __builtin_amdgcn_s_setprio(1); _Pragma("unroll") for (int m = 0; m < 4; ++m) _Pragma("unroll") for (int n = 0; n < 2; ++n) _Pragma("unroll") for (int k = 0; k < 2; ++k) \
        acc[ai][bj][m][n] = __builtin_amdgcn_mfma_f32_16x16x32_bf16(Bt[n][k], At[m][k], acc[ai][bj][m][n], 0, 0, 0); __builtin_amdgcn_s_setprio(0); } while (0)
#define PG8_WAIT_V(n) asm volatile("s_waitcnt vmcnt(" #n ")" ::: "memory")
#define PG8_WAIT_L(n) asm volatile("s_waitcnt lgkmcnt(" #n ")" ::: "memory")
#define PG8_BAR __builtin_amdgcn_s_barrier()
#define PG8_SCHED __builtin_amdgcn_sched_barrier(0)
    Unit cur, nxt; int ui = 0;
    if (!g.next(0, G, c, cur)) return;
    f32x4 acc[2][2][4][2];
#pragma unroll
    for (int a = 0; a < 2; ++a)
#pragma unroll
        for (int b = 0; b < 2; ++b)
#pragma unroll
            for (int m = 0; m < 4; ++m)
#pragma unroll
                for (int n = 0; n < 2; ++n) acc[a][b][m][n] = (f32x4){0.f, 0.f, 0.f, 0.f};
    bf16x8 At[4][2], B0[2][2], B1[2][2];
    const char* cA = g.abase(cur); const char* cB = g.bbase(cur);
    PG8_STAGE(PG8_SB(0, 0), cB, voffB); PG8_STAGE(PG8_SB(0, 1), cB + hstepB, voffB); PG8_STAGE(PG8_SA(0, 0), cA, voffA); PG8_STAGE(PG8_SA(0, 1), cA + hstepA, voffA);
    if (wr == 1) PG8_BAR;
    PG8_WAIT_V(2); PG8_BAR;
    PG8_STAGE(PG8_SB(1, 0), cB + g.koffB(1), voffB); PG8_STAGE(PG8_SA(1, 0), cA + g.koffA(1), voffA); PG8_STAGE(PG8_SB(1, 1), cB + hstepB + g.koffB(1), voffB);
    PG8_WAIT_V(6); PG8_BAR;
    for (;;) {
        const bool has_next = g.next(ui + 1, G, c, nxt);
        const char* nA = has_next ? g.abase(nxt) : cA; const char* nB = has_next ? g.bbase(nxt) : cB;
#pragma nounroll
        for (int t = 0; t < nt; t += 2) {
            const bool last = (t == nt - 2);
            const char* a1 = cA + g.koffA(t + 1);
            const char* a2 = last ? nA : cA + g.koffA(t + 2); const char* b2 = last ? nB : cB + g.koffB(t + 2);
            const char* a3 = last ? nA + g.koffA(1) : cA + g.koffA(t + 3); const char* b3 = last ? nB + g.koffB(1) : cB + g.koffB(t + 3);
            if constexpr (Epi::MIDK >= 0) { if (t == Epi::MIDK) E.midk(acc, cur, wr, wc, fr, fq); }
            PG8_LDB(B0, 0, 0); PG8_LDB(B1, 0, 1); PG8_SCHED; PG8_LDA(At, 0, 0); PG8_STAGE(PG8_SA(1, 1), a1 + hstepA, voffA);
            PG8_WAIT_V(8); PG8_WAIT_L(0); PG8_BAR; PG8_MMA(0, 0, At, B0); PG8_MMA(0, 1, At, B1); PG8_BAR; PG8_SCHED;
            PG8_LDA(At, 0, 1); PG8_STAGE(PG8_SB(0, 0), b2, voffB); PG8_STAGE(PG8_SB(0, 1), b2 + hstepB, voffB); PG8_STAGE(PG8_SA(0, 0), a2, voffA);
            PG8_WAIT_V(8); PG8_WAIT_L(0); PG8_BAR; PG8_MMA(1, 0, At, B0); PG8_MMA(1, 1, At, B1); PG8_BAR; PG8_SCHED;
            PG8_LDB(B0, 1, 0); PG8_LDB(B1, 1, 1); PG8_SCHED; PG8_LDA(At, 1, 0); PG8_STAGE(PG8_SA(0, 1), a2 + hstepA, voffA);
            PG8_WAIT_V(8); PG8_WAIT_L(0); PG8_BAR; PG8_MMA(0, 0, At, B0); PG8_MMA(0, 1, At, B1); PG8_BAR; PG8_SCHED;
            PG8_LDA(At, 1, 1); PG8_STAGE(PG8_SB(1, 0), b3, voffB); PG8_STAGE(PG8_SB(1, 1), b3 + hstepB, voffB); PG8_STAGE(PG8_SA(1, 0), a3, voffA);
            PG8_WAIT_V(8); PG8_WAIT_L(0); PG8_BAR; PG8_MMA(1, 0, At, B0); PG8_MMA(1, 1, At, B1); PG8_BAR; PG8_SCHED;
        }
        if (wr == 0) PG8_BAR;
        E(acc, cur, wr, wc, fr, fq, lds);
        if (!has_next) break;
#pragma unroll
        for (int a = 0; a < 2; ++a)
#pragma unroll
            for (int b = 0; b < 2; ++b)
#pragma unroll
                for (int m = 0; m < 4; ++m)
#pragma unroll
                    for (int n = 0; n < 2; ++n) acc[a][b][m][n] = (f32x4){0.f, 0.f, 0.f, 0.f};
        cur = nxt; cA = nA; cB = nB; ++ui;
        if (wr == 1) PG8_BAR;
    }
    PG8_WAIT_V(0);
    PG8_BAR;
#undef PG8_SA
#undef PG8_SB
#undef PG8_STAGE
#undef PG8_LDA
#undef PG8_LDB
#undef PG8_MMA
#undef PG8_WAIT_V
#undef PG8_WAIT_L
#undef PG8_BAR
#undef PG8_SCHED
}
#define EPI_ARGS f32x4 (&acc)[2][2][4][2], const Unit& u, int wr, int wc, int fr, int fq
struct EpiBase { static constexpr int MIDK = -1; __device__ __forceinline__ void midk(EPI_ARGS) const {} };

struct EpiZ : EpiBase {
    bf16_t* U; bf16_t* XL; bf16_t* GG;
    __device__ __forceinline__ void operator()(EPI_ARGS, LAS unsigned char*) const {
        const int row0 = u.pm * BM + wr * 64 + fr;
#pragma unroll
        for (int ai = 0; ai < 2; ++ai)
#pragma unroll
            for (int m = 0; m < 4; ++m) {
                const int r = row0 + ai * HALF + m * 16, b = r >> 11, t = r & 2047;
#pragma unroll
                for (int bj = 0; bj < 2; ++bj) {
                    const int c = u.pn * BM + bj * HALF + wc * 32 + fq * 8;
                    f32x4 v0 = acc[ai][bj][m][0], v1 = acc[ai][bj][m][1];
                    if (u.pn < 2) {
                        const int g = c >> 4, hi0 = c & 15;
                        *(u32x4*)(U + ((size_t)(g * 1024 + b * NCH + (t >> 5)) * 640 + (t & 31) * 16 + hi0)) = pack8(v0, v1);
                    } else if (u.pn < 4) {
                        *(u32x4*)(XL + ((size_t)(b * XLROWS + 3 + t) * 512 + (c - 512))) = pack8(v0, v1);
                    } else {
#pragma unroll
                        for (int j = 0; j < 4; ++j) { v0[j] = gelu_t(v0[j]); v1[j] = gelu_t(v1[j]); }
                        *(u32x4*)(GG + ((size_t)r * 512 + (c - 1024))) = pack8(v0, v1);
                    }
                }
                asm volatile("" ::: "memory");
            }
    }
};
struct EpiBf16 : EpiBase {
    bf16_t* O; int ldc; int bdiv; long ob0, ob1;
    __device__ __forceinline__ void operator()(EPI_ARGS, LAS unsigned char*) const {
        bf16_t* base = O + (long)(u.pb / bdiv) * ob0 + (long)(u.pb % bdiv) * ob1;
        const int row0 = u.pm * BM + wr * 64 + fr;
#pragma unroll
        for (int ai = 0; ai < 2; ++ai)
#pragma unroll
            for (int m = 0; m < 4; ++m) {
                bf16_t* rowp = base + (size_t)(row0 + ai * HALF + m * 16) * ldc + u.pn * BM + wc * 32 + fq * 8;
#pragma unroll
                for (int bj = 0; bj < 2; ++bj) *(u32x4*)(rowp + bj * HALF) = pack8(acc[ai][bj][m][0], acc[ai][bj][m][1]);
            }
    }
};
struct EpiXend : EpiBase {
    float* X;
    __device__ __forceinline__ void operator()(EPI_ARGS, LAS unsigned char*) const {
        const int row0 = u.pm * BM + wr * 64 + fr;
#pragma unroll
        for (int ai = 0; ai < 2; ++ai)
#pragma unroll
            for (int m = 0; m < 4; ++m) {
                float* rowp = X + ((size_t)u.pb * 1024 + row0 + ai * HALF + m * 16) * 128 + wc * 32 + fq * 8;
                *(f32x4*)(rowp) = acc[ai][0][m][0]; *(f32x4*)(rowp + 4) = acc[ai][0][m][1];
            }
    }
};
struct EpiGates : EpiBase {
    const bf16_t* XL; const float* cw; const float* cb; const float* gbias; const float* sp8; float* LA; float* LB;
    __device__ __forceinline__ void operator()(EPI_ARGS, LAS unsigned char*) const {
        const int hp = u.pb >> 4, b = u.pb & 15, rt = u.pm;
        const int ch0 = hp * 128 + wc * 32 + fq * 8;
        const float* gb = gbias + hp * 256 + wc * 32 + fq * 8;
#pragma unroll
        for (int ai = 0; ai < 2; ++ai)
#pragma unroll
            for (int m = 0; m < 4; ++m) {
                const int t = rt * 256 + ai * HALF + wr * 64 + m * 16 + fr;
                const bf16_t* xr = XL + ((size_t)(b * XLROWS + t) * 512 + ch0);
                const size_t o = ((size_t)(b * S + t)) * 512 + ch0;
#pragma unroll
                for (int n = 0; n < 2; ++n) {
                    f32x4 xc = *(const f32x4*)(cb + ch0 + 4 * n);
#pragma unroll
                    for (int k = 0; k < 4; ++k) { const u32x2 wv = *(const u32x2*)(xr + (size_t)k * 512 + 4 * n); const f32x4 w = *(const f32x4*)(cw + k * 512 + ch0 + 4 * n);
                        xc[0] += w[0] * bflo(wv.x); xc[1] += w[1] * bfhi(wv.x); xc[2] += w[2] * bflo(wv.y); xc[3] += w[3] * bfhi(wv.y); }
                    const f32x4 ba = *(const f32x4*)(gb + 4 * n), bx = *(const f32x4*)(gb + 128 + 4 * n), spv = *(const f32x4*)(sp8 + ch0 + 4 * n);
                    f32x4 av, bv;
#pragma unroll
                    for (int j = 0; j < 4; ++j) {
                        const float r = sigm(acc[ai][0][m][n][j] + ba[j]), ig = sigm(acc[ai][1][m][n][j] + bx[j]);
                        const float la = -r * spv[j];
                        const float a = fast_exp(la);
                        const float x2 = 2.0f * la;
                        const float om = (x2 > -0.1f) ? (-x2 * (1.0f + x2 * (0.5f + x2 * (0.16666667f + x2 * 0.041666668f)))) : (1.0f - a * a);
                        av[j] = a; bv[j] = __builtin_sqrtf(om) * ig * xc[j];
                    }
                    *(f32x4*)(LA + o + 4 * n) = av; *(f32x4*)(LB + o + 4 * n) = bv;
                    asm volatile("" ::: "memory");
                }
            }
    }
};
struct EpiS5 : EpiBase {
    const bf16_t* U; const float* dd; bf16_t* Y1;
    __device__ __forceinline__ void operator()(EPI_ARGS, LAS unsigned char*) const {
        const int g = u.pb; const int row0 = u.pm * BM + wr * 64 + fr;
#pragma unroll
        for (int bj = 0; bj < 2; ++bj) {
            const int c = u.pn * BM + bj * HALF + wc * 32 + fq * 8, i = c >> 4, ho0 = c & 15;
            const f32x4 d0 = *(const f32x4*)(dd + g * 16 + ho0), d1 = *(const f32x4*)(dd + g * 16 + ho0 + 4);
#pragma unroll
            for (int ai = 0; ai < 2; ++ai)
#pragma unroll
                for (int m = 0; m < 4; ++m) {
                    const int R = row0 + ai * HALF + m * 16, b = R >> 6, chn = R & 63;
                    const u32x4 uw = *(const u32x4*)(U + ((size_t)(g * 1024 + R) * 640 + c)); f32x4 u0, u1; unpack8(uw, u0, u1);
                    f32x4 v0 = acc[ai][bj][m][0] + d0 * u0, v1 = acc[ai][bj][m][1] + d1 * u1;
#pragma unroll
                    for (int j = 0; j < 4; ++j) { v0[j] = gelu_t(v0[j]); v1[j] = gelu_t(v1[j]); }
                    *(u32x4*)(Y1 + ((size_t)(b * S + chn * CH + i) * 512 + g * 16 + ho0)) = pack8(v0, v1);
                    asm volatile("" ::: "memory");
                }
        }
    }
};
struct EpiGlu : EpiBase {
    const bf16_t* Y1; const float* bg; bf16_t* YC; float* ssq;
    __device__ __forceinline__ void operator()(EPI_ARGS, LAS unsigned char*) const {
        const int row0 = u.pm * BM + wr * 64 + fr;
        float ss[2][4];
#pragma unroll
        for (int ai = 0; ai < 2; ++ai)
#pragma unroll
            for (int m = 0; m < 4; ++m) ss[ai][m] = 0.f;
#pragma unroll
        for (int bj = 0; bj < 2; ++bj) {
            const int c = u.pn * BM + bj * HALF + wc * 32 + fq * 8;
            const f32x4 g0 = *(const f32x4*)(bg + c), g1 = *(const f32x4*)(bg + c + 4);
#pragma unroll
            for (int ai = 0; ai < 2; ++ai)
#pragma unroll
                for (int m = 0; m < 4; ++m) {
                    const size_t r = row0 + ai * HALF + m * 16;
                    const u32x4 yw = *(const u32x4*)(Y1 + r * 512 + c); f32x4 y0, y1; unpack8(yw, y0, y1);
                    f32x4 v0, v1;
#pragma unroll
                    for (int j = 0; j < 4; ++j) { v0[j] = y0[j] * sigm(acc[ai][bj][m][0][j] + g0[j]); v1[j] = y1[j] * sigm(acc[ai][bj][m][1][j] + g1[j]); ss[ai][m] += v0[j] * v0[j] + v1[j] * v1[j]; }
                    *(u32x4*)(YC + r * 1024 + c) = pack8(v0, v1);
                    asm volatile("" ::: "memory");
                }
        }
#pragma unroll
        for (int ai = 0; ai < 2; ++ai)
#pragma unroll
            for (int m = 0; m < 4; ++m) { float s = ss[ai][m]; s += __shfl_xor(s, 16); s += __shfl_xor(s, 32); if (fq == 0) atomicAdd(ssq + row0 + ai * HALF + m * 16, s); }
    }
};
template <int MODE, bool HASB, int MK>
struct EpiRes {
    static constexpr int MIDK = MK;
    const float* prev; const float* pstats; const float* pg; const float* pb_; float* vout; bf16_t* vb; float* ostats; const float* ssq;
    __device__ __forceinline__ void midk(EPI_ARGS) const {
        const int row0 = u.pm * BM + wr * 64 + fr;
#pragma unroll
        for (int ai = 0; ai < 2; ++ai)
#pragma unroll
            for (int m = 0; m < 4; ++m) { const float s = __builtin_amdgcn_rsqf(ssq[row0 + ai * HALF + m * 16] * (1.0f / 512.0f) + 1e-6f);
#pragma unroll
                for (int bj = 0; bj < 2; ++bj)
#pragma unroll
                    for (int n = 0; n < 2; ++n) acc[ai][bj][m][n] = acc[ai][bj][m][n] * s; }
    }
    __device__ __forceinline__ void operator()(EPI_ARGS, LAS unsigned char*) const {
        const int row0 = u.pm * BM + wr * 64 + fr;
        float s1[2][4], s2[2][4];
#pragma unroll
        for (int ai = 0; ai < 2; ++ai)
#pragma unroll
            for (int m = 0; m < 4; ++m) { s1[ai][m] = 0.f; s2[ai][m] = 0.f; }
#pragma unroll
        for (int bj = 0; bj < 2; ++bj) {
            const int c = u.pn * BM + bj * HALF + wc * 32 + fq * 8;
            const f32x4 g0 = *(const f32x4*)(pg + c), g1 = *(const f32x4*)(pg + c + 4), b0 = *(const f32x4*)(pb_ + c), b1 = *(const f32x4*)(pb_ + c + 4);
#pragma unroll
            for (int ai = 0; ai < 2; ++ai)
#pragma unroll
                for (int m = 0; m < 4; ++m) {
                    const int r = row0 + ai * HALF + m * 16;
                    const f32x2 st = *(const f32x2*)(pstats + 2 * (size_t)r);
                    float mm, rr;
                    if (MODE == 0) { mm = st.x; rr = st.y; }
                    else { mm = st.x * (1.0f / 1024.0f); rr = __builtin_amdgcn_rsqf(st.y * (1.0f / 1024.0f) - mm * mm + 1e-5f); }
                    const size_t o = (size_t)r * 1024 + c;
                    const f32x4 p0 = *(const f32x4*)(prev + o), p1 = *(const f32x4*)(prev + o + 4);
                    const f32x4 v0 = ((p0 - mm) * rr * g0 + b0) * ALPHA + acc[ai][bj][m][0], v1 = ((p1 - mm) * rr * g1 + b1) * ALPHA + acc[ai][bj][m][1];
                    *(f32x4*)(vout + o) = v0; *(f32x4*)(vout + o + 4) = v1;
                    if (HASB) *(u32x4*)(vb + o) = pack8(v0, v1);
#pragma unroll
                    for (int j = 0; j < 4; ++j) { s1[ai][m] += v0[j] + v1[j]; s2[ai][m] += v0[j] * v0[j] + v1[j] * v1[j]; }
                    asm volatile("" ::: "memory");
                }
        }
#pragma unroll
        for (int ai = 0; ai < 2; ++ai)
#pragma unroll
            for (int m = 0; m < 4; ++m) { float a = s1[ai][m], q = s2[ai][m]; a += __shfl_xor(a, 16); a += __shfl_xor(a, 32); q += __shfl_xor(q, 16); q += __shfl_xor(q, 32);
                if (fq == 0) { float* d = ostats + 2 * (size_t)(row0 + ai * HALF + m * 16); atomicAdd(d, a); atomicAdd(d + 1, q); } }
    }
};
template <int ACT>
struct EpiFold : EpiBase {
    const float* pstats; const float* c1; const float* c2; bf16_t* O; int ldc; float sc;
    __device__ __forceinline__ void operator()(EPI_ARGS, LAS unsigned char*) const {
        const int row0 = u.pm * BM + wr * 64 + fr;
        float mu[2][4], rs[2][4];
#pragma unroll
        for (int ai = 0; ai < 2; ++ai)
#pragma unroll
            for (int m = 0; m < 4; ++m) { const f32x2 st = *(const f32x2*)(pstats + 2 * (size_t)(row0 + ai * HALF + m * 16));
                const float mm = st.x * (1.0f / 1024.0f); mu[ai][m] = mm; rs[ai][m] = __builtin_amdgcn_rsqf(st.y * (1.0f / 1024.0f) - mm * mm + 1e-5f); }
#pragma unroll
        for (int bj = 0; bj < 2; ++bj) {
            const int c = u.pn * BM + bj * HALF + wc * 32 + fq * 8;
            const f32x4 k0 = *(const f32x4*)(c1 + c), k1 = *(const f32x4*)(c1 + c + 4), e0 = *(const f32x4*)(c2 + c), e1 = *(const f32x4*)(c2 + c + 4);
#pragma unroll
            for (int ai = 0; ai < 2; ++ai)
#pragma unroll
                for (int m = 0; m < 4; ++m) {
                    const float mm = mu[ai][m], rr = rs[ai][m];
                    f32x4 v0 = (acc[ai][bj][m][0] - k0 * mm) * rr + e0, v1 = (acc[ai][bj][m][1] - k1 * mm) * rr + e1;
                    if (ACT == 0) { v0 = v0 * sc; v1 = v1 * sc; }
                    else {
#pragma unroll
                        for (int j = 0; j < 4; ++j) { const float a = fmaxf(v0[j], 0.f), b = fmaxf(v1[j], 0.f); v0[j] = a * a; v1[j] = b * b; } }
                    *(u32x4*)(O + (size_t)(row0 + ai * HALF + m * 16) * ldc + c) = pack8(v0, v1);
                    asm volatile("" ::: "memory");
                }
        }
    }
};
struct EpiSoftmax : EpiBase {
    bf16_t* P;
    __device__ __forceinline__ void operator()(EPI_ARGS, LAS unsigned char* lds) const {
        LAS f32x2* X = (LAS f32x2*)(lds + LDS_X);
        float mw[2][4];
#pragma unroll
        for (int ai = 0; ai < 2; ++ai)
#pragma unroll
            for (int m = 0; m < 4; ++m) {
                float mx = -3.0e38f;
#pragma unroll
                for (int bj = 0; bj < 2; ++bj)
#pragma unroll
                    for (int n = 0; n < 2; ++n)
#pragma unroll
                        for (int j = 0; j < 4; ++j) mx = fmaxf(mx, acc[ai][bj][m][n][j]);
                mx = fmaxf(mx, __shfl_xor(mx, 16)); mx = fmaxf(mx, __shfl_xor(mx, 32));
                float sm = 0.f;
#pragma unroll
                for (int bj = 0; bj < 2; ++bj)
#pragma unroll
                    for (int n = 0; n < 2; ++n)
#pragma unroll
                        for (int j = 0; j < 4; ++j) { const float e = fast_exp(acc[ai][bj][m][n][j] - mx); acc[ai][bj][m][n][j] = e; sm += e; }
                sm += __shfl_xor(sm, 16); sm += __shfl_xor(sm, 32);
                mw[ai][m] = mx;
                if (fq == 0) X[(ai * HALF + wr * 64 + m * 16 + fr) * 4 + wc] = (f32x2){mx, sm};
            }
        asm volatile("s_waitcnt lgkmcnt(0)" ::: "memory"); __builtin_amdgcn_s_barrier(); asm volatile("" ::: "memory");
        const int row0 = u.pm * BM + wr * 64 + fr;
#pragma unroll
        for (int ai = 0; ai < 2; ++ai)
#pragma unroll
            for (int m = 0; m < 4; ++m) {
                const int rl = ai * HALF + wr * 64 + m * 16 + fr;
                const f32x2 x0 = X[rl * 4 + 0], x1 = X[rl * 4 + 1], x2 = X[rl * 4 + 2], x3 = X[rl * 4 + 3];
                const float Mx = fmaxf(fmaxf(x0.x, x1.x), fmaxf(x2.x, x3.x));
                const float tot = x0.y * fast_exp(x0.x - Mx) + x1.y * fast_exp(x1.x - Mx) + x2.y * fast_exp(x2.x - Mx) + x3.y * fast_exp(x3.x - Mx);
                const float scl = fast_exp(mw[ai][m] - Mx) * fast_rcp(tot);
                bf16_t* rowp = P + ((size_t)u.pb * S + row0 + ai * HALF + m * 16) * 256 + wc * 32 + fq * 8;
#pragma unroll
                for (int bj = 0; bj < 2; ++bj) *(u32x4*)(rowp + bj * HALF) = pack8(acc[ai][bj][m][0] * scl, acc[ai][bj][m][1] * scl);
            }
        asm volatile("s_waitcnt lgkmcnt(0)" ::: "memory");
    }
};
struct Params { const float* in[39]; float* out; unsigned char* ws; int ph_lo, ph_hi; };
typedef const Params __attribute__((address_space(4)))* KP;
__device__ __forceinline__ KP kargs() { KP q = (KP)__builtin_amdgcn_kernarg_segment_ptr(); asm volatile("" : "+s"(q)); return q; }

__device__ __forceinline__ void p0_transpose_tile(const float* __restrict__ W, int K, int N, const float* sA, const float* sB, int split, bf16_t* __restrict__ Wt, int tile, LAS float* scr, int tid) {
    const int tiles_n = N >> 6, tk = tile / tiles_n, tn = tile % tiles_n, k0 = tk * 64, n0 = tn * 64;
#pragma unroll
    for (int j = 0; j < 8; ++j) { const int i = tid + 512 * j, k = i >> 6, n = i & 63; float s = 1.f; if (sA) { const int kk = k0 + k; s = (kk < split) ? sA[kk] : sB[kk - split]; }
        scr[k * 65 + n] = W[(size_t)(k0 + k) * N + n0 + n] * s; }
    __syncthreads();
    { const int n = tid >> 3, ks = (tid & 7) * 8; f32x4 a, b;
#pragma unroll
      for (int j = 0; j < 4; ++j) { a[j] = scr[(ks + j) * 65 + n]; b[j] = scr[(ks + 4 + j) * 65 + n]; }
      *(u32x4*)(Wt + (size_t)(n0 + n) * K + k0 + ks) = pack8(a, b); }
    __syncthreads();
}
__device__ __forceinline__ void p0_colsum(const float* __restrict__ W, int N, const float* g, const float* b, float* c1, float* c2, int item, LAS float* scr, int tid) {
    const int n = item * 64 + (tid & 63), ks = tid >> 6; float s1 = 0.f, s2 = 0.f;
    for (int k = ks * 128; k < ks * 128 + 128; ++k) { const float w = W[(size_t)k * N + n]; s1 += bf2f(f2bf(g[k] * w)); s2 += b[k] * w; }
    scr[(ks * 64 + (tid & 63)) * 2] = s1; scr[(ks * 64 + (tid & 63)) * 2 + 1] = s2;
    __syncthreads();
    if (tid < 64) { float a = 0.f, q = 0.f;
#pragma unroll
        for (int j = 0; j < 8; ++j) { a += scr[(j * 64 + tid) * 2]; q += scr[(j * 64 + tid) * 2 + 1]; }
        c1[n] = a; c2[n] = q; }
    __syncthreads();
}
__device__ __forceinline__ void ln_row_bf16(const float* __restrict__ x, const float* g, const float* b, bf16_t* __restrict__ o, float* st, int lane) {
    f32x4 v[4]; float s = 0.f;
#pragma unroll
    for (int j = 0; j < 4; ++j) { v[j] = *(const f32x4*)(x + j * 256 + lane * 4); s += (v[j][0] + v[j][1]) + (v[j][2] + v[j][3]); }
    const float mu = wave_sum(s) * (1.0f / 1024.0f); float q = 0.f;
#pragma unroll
    for (int j = 0; j < 4; ++j) { v[j] = v[j] - mu; q += (v[j][0] * v[j][0] + v[j][1] * v[j][1]) + (v[j][2] * v[j][2] + v[j][3] * v[j][3]); }
    const float rstd = rsqrtf(wave_sum(q) * (1.0f / 1024.0f) + 1e-5f);
#pragma unroll
    for (int j = 0; j < 4; ++j) { const f32x4 gg = *(const f32x4*)(g + j * 256 + lane * 4), bb = *(const f32x4*)(b + j * 256 + lane * 4); const f32x4 y = v[j] * rstd * gg + bb;
        u32x2 w; w.x = cvt_pk_bf16(y[0], y[1]); w.y = cvt_pk_bf16(y[2], y[3]); *(u32x2*)(o + j * 256 + lane * 4) = w; }
    if (st && lane == 0) { st[0] = mu; st[1] = rstd; }
}
__device__ __forceinline__ void p0_s5_tables(KP p, int g, LAS unsigned char* lds, int tid) {
    LAS float* lam = (LAS float*)lds;
    LAS float* Bb = lam + 33 * 128;
    LAS float* Cc = Bb + 2048;
    LAS float* Kt = Cc + 2048;
    const float* a_re = p->in[5] + g * 64; const float* a_im = p->in[6] + g * 64; const float dt = expf(p->in[7][g]);
    for (int i = tid; i < 33 * 64; i += NTHREADS) { const int tau = i >> 6, pp = i & 63; const float mag = expf((float)tau * dt * a_re[pp]); float sn, cs; sincosf((float)tau * dt * a_im[pp], &sn, &cs);
        lam[i * 2] = mag * cs; lam[i * 2 + 1] = mag * sn; }
    for (int i = tid; i < 1024; i += NTHREADS) { const int pp = i >> 4, h = i & 15;
        const float ar = a_re[pp], ai = a_im[pp]; const float mag = expf(dt * ar); float sn, cs; sincosf(dt * ai, &sn, &cs); const float lr = mag * cs, li = mag * sn;
        const float den = ar * ar + ai * ai; const float qr = ((lr - 1.f) * ar + li * ai) / den, qi = (li * ar - (lr - 1.f) * ai) / den;
        const float br = p->in[8][(g * 64 + pp) * 16 + h], bi = p->in[9][(g * 64 + pp) * 16 + h];
        Bb[i * 2] = qr * br - qi * bi; Bb[i * 2 + 1] = qr * bi + qi * br;
        const int ho = i >> 6, p2 = i & 63; Cc[i * 2] = p->in[10][(g * 16 + ho) * 64 + p2]; Cc[i * 2 + 1] = p->in[11][(g * 16 + ho) * 64 + p2]; }
    __syncthreads();
    { const int e = tid >> 1, ho = e >> 4, hi = e & 15, half = tid & 1;
      for (int tau = 0; tau < 32; ++tau) { float s = 0.f;
          for (int pp = half * 32; pp < half * 32 + 32; ++pp) { const float cr = Cc[(ho * 64 + pp) * 2], ci = Cc[(ho * 64 + pp) * 2 + 1], lr = lam[(tau * 64 + pp) * 2], li = lam[(tau * 64 + pp) * 2 + 1];
              const float xr = cr * lr - ci * li, xi = cr * li + ci * lr; s += xr * Bb[(pp * 16 + hi) * 2] - xi * Bb[(pp * 16 + hi) * 2 + 1]; }
          s += __shfl_xor(s, 1); if (half == 0) Kt[tau * 256 + e] = s; } }
    __syncthreads();
    bf16_t* T = (bf16_t*)(p->ws + WS_S5T) + (size_t)g * 512 * 640;
    for (int q = tid; q < 512 * 80; q += NTHREADS) { const int n = q / 80, kc = q % 80, i = n >> 4, ho = n & 15; f32x4 a, b;
        if (kc < 64) { const int j = kc >> 1, hi0 = (kc & 1) * 8;
            if (i >= j) { LAS float* src = Kt + (i - j) * 256 + ho * 16 + hi0;
#pragma unroll
                for (int x = 0; x < 4; ++x) { a[x] = src[x]; b[x] = src[4 + x]; } }
            else { a = (f32x4){0.f, 0.f, 0.f, 0.f}; b = a; } }
        else { const int p0 = (kc - 64) * 4;
#pragma unroll
            for (int x = 0; x < 4; ++x) { const int pp = p0 + x; const float cr = Cc[(ho * 64 + pp) * 2], ci = Cc[(ho * 64 + pp) * 2 + 1], lr = lam[((i + 1) * 64 + pp) * 2], li = lam[((i + 1) * 64 + pp) * 2 + 1];
                const float re = cr * lr - ci * li, im = cr * li + ci * lr; if (x < 2) { a[2 * x] = re; a[2 * x + 1] = -im; } else { b[2 * (x - 2)] = re; b[2 * (x - 2) + 1] = -im; } } }
        *(u32x4*)(T + (size_t)n * 640 + kc * 8) = pack8(a, b); }
    bf16_t* Pm = (bf16_t*)(p->ws + WS_S5P) + (size_t)g * 256 * 512;
    for (int q = tid; q < 256 * 64; q += NTHREADS) { const int n = q >> 6, kc = q & 63; f32x4 a = (f32x4){0.f, 0.f, 0.f, 0.f}, b = a;
        if (n < 128) { const int pp = n >> 1, im = n & 1, j = kc >> 1, hi0 = (kc & 1) * 8; const float lr = lam[((CH - 1 - j) * 64 + pp) * 2], li = lam[((CH - 1 - j) * 64 + pp) * 2 + 1];
#pragma unroll
            for (int x = 0; x < 8; ++x) { const float br = Bb[(pp * 16 + hi0 + x) * 2], bi = Bb[(pp * 16 + hi0 + x) * 2 + 1]; const float v = im ? (lr * bi + li * br) : (lr * br - li * bi); if (x < 4) a[x] = v; else b[x - 4] = v; } }
        *(u32x4*)(Pm + (size_t)n * 512 + kc * 8) = pack8(a, b); }
    if (tid < 128) ((float*)(p->ws + WS_LAML))[g * 128 + tid] = lam[CH * 128 + tid];
    __syncthreads();
}
__device__ __forceinline__ void p0_prep(KP p, LAS unsigned char* lds, int G, int c) {
    const int tid = threadIdx.x, lane = tid & 63, wave = tid >> 6;
    LAS float* scr = (LAS float*)lds;
    unsigned char* ws = p->ws;
    constexpr int I_S5 = 32, T_IN = 16 * 24, T_GLU = 64, T_SQ = 256, T_F1 = 16 * 64, T_F2 = 64 * 16;
    constexpr int I_TR = T_IN + T_GLU + 5 * T_SQ + T_F1 + T_F2, I_CS = 16 + 64, I_GT = 128, I_GB = 2, I_SP = 1, I_Z = 112 + 6, I_LNX = M / 8, I_LNM = 4096 / 8;
    constexpr int NITEMS = I_S5 + I_TR + I_CS + I_GT + I_GB + I_SP + I_Z + I_LNX + I_LNM;
    for (int it = c; it < NITEMS; it += G) {
        int r = it;
        if (r < I_S5) { p0_s5_tables(p, r, lds, tid); continue; } r -= I_S5;
        if (r < I_TR) {
            if (r < T_IN) { p0_transpose_tile(p->in[4], 1024, 1536, nullptr, nullptr, 0, (bf16_t*)(ws + WS_WIN), r, scr, tid); continue; } r -= T_IN;
            if (r < T_GLU) { p0_transpose_tile(p->in[13], 512, 512, nullptr, nullptr, 0, (bf16_t*)(ws + WS_WGLU), r, scr, tid); continue; } r -= T_GLU;
            if (r < T_SQ) { p0_transpose_tile(p->in[24], 1024, 1024, p->in[22], p->in[23], 512, (bf16_t*)(ws + WS_WMIX), r, scr, tid); continue; } r -= T_SQ;
            if (r < T_SQ) { p0_transpose_tile(p->in[29], 1024, 1024, p->in[25], p->in[25], 1 << 30, (bf16_t*)(ws + WS_WQ), r, scr, tid); continue; } r -= T_SQ;
            if (r < T_SQ) { p0_transpose_tile(p->in[30], 1024, 1024, nullptr, nullptr, 0, (bf16_t*)(ws + WS_WK), r, scr, tid); continue; } r -= T_SQ;
            if (r < T_SQ) { p0_transpose_tile(p->in[31], 1024, 1024, nullptr, nullptr, 0, (bf16_t*)(ws + WS_WV), r, scr, tid); continue; } r -= T_SQ;
            if (r < T_SQ) { p0_transpose_tile(p->in[32], 1024, 1024, nullptr, nullptr, 0, (bf16_t*)(ws + WS_WO), r, scr, tid); continue; } r -= T_SQ;
            if (r < T_F1) { p0_transpose_tile(p->in[35], 1024, 4096, p->in[33], p->in[33], 1 << 30, (bf16_t*)(ws + WS_WF1), r, scr, tid); continue; } r -= T_F1;
            p0_transpose_tile(p->in[36], 4096, 1024, nullptr, nullptr, 0, (bf16_t*)(ws + WS_WF2), r, scr, tid); continue;
        } r -= I_TR;
        if (r < I_CS) {
            if (r < 16) p0_colsum(p->in[29], 1024, p->in[25], p->in[26], (float*)(ws + WS_C1Q), (float*)(ws + WS_C2Q), r, scr, tid);
            else p0_colsum(p->in[35], 4096, p->in[33], p->in[34], (float*)(ws + WS_C1F), (float*)(ws + WS_C2F), r - 16, scr, tid);
            continue;
        } r -= I_CS;
        if (r < I_GT) {
            const int q = r * 512 + tid, hp = q >> 14, n = (q >> 6) & 255, k0 = (q & 63) * 8;
            const int tap = k0 >> 7, cc0 = k0 & 127, co = hp * 128 + (n & 127), ho = co >> 6; const float* Wg = (n >> 7) ? p->in[19] : p->in[17];
            f32x4 a = (f32x4){0.f, 0.f, 0.f, 0.f}, b = a;
            if (((hp * 128 + cc0) >> 6) == ho) {
#pragma unroll
                for (int x = 0; x < 8; ++x) { const int ci = hp * 128 + cc0 + x; const float v = p->in[15][tap * 512 + ci] * Wg[(ho * 64 + (ci & 63)) * 64 + (co & 63)]; if (x < 4) a[x] = v; else b[x - 4] = v; } }
            *(u32x4*)((bf16_t*)(ws + WS_GATES) + ((size_t)(hp * 256 + n) * 512 + k0)) = pack8(a, b);
            continue;
        } r -= I_GT;
        if (r < I_GB) { const int q = r * 512 + tid, hp = q >> 8, n = q & 255, co = hp * 128 + (n & 127), ho = co >> 6; const float* Wg = (n >> 7) ? p->in[19] : p->in[17];
            float s = ((n >> 7) ? p->in[20] : p->in[18])[co];
            for (int i = 0; i < 64; ++i) s += p->in[16][ho * 64 + i] * Wg[(ho * 64 + i) * 64 + (co & 63)];
            ((float*)(ws + WS_GBIAS))[q] = s; continue; } r -= I_GB;
        if (r < I_SP) { ((float*)(ws + WS_SP8))[tid] = 8.0f * log1pf(expf(-p->in[21][tid])); continue; } r -= I_SP;
        if (r < I_Z) {
            if (r < 112) *(u32x4*)(ws + WS_ZERO_BEG + ((size_t)r * 512 + tid) * 16) = (u32x4){0u, 0u, 0u, 0u};
            else { const int q = (r - 112) * 512 + tid;
                const int b = q / 192, w = q % 192; *(u32x4*)(ws + WS_XL + ((size_t)b * XLROWS * 512) * 2 + (size_t)w * 16) = (u32x4){0u, 0u, 0u, 0u}; }
            continue;
        } r -= I_Z;
        if (r < I_LNX) { const int row = r * 8 + wave; ln_row_bf16(p->in[0] + (size_t)row * 1024, p->in[2], p->in[3], (bf16_t*)(ws + WS_H0B) + (size_t)row * 1024, (float*)(ws + WS_STATS0) + 2 * row, lane); continue; } r -= I_LNX;
        { const int row = r * 8 + wave; ln_row_bf16(p->in[1] + (size_t)row * 1024, p->in[27], p->in[28], (bf16_t*)(ws + WS_MEMN) + (size_t)row * 1024, nullptr, lane); }
    }
}
__device__ __forceinline__ void p3_s5_scan(KP p, int c) {
    const int gt = c * NTHREADS + threadIdx.x; if (gt >= NG * B * 64) return;
    const int g = gt >> 10, b = (gt >> 6) & 15, pp = gt & 63;
    const float lr = ((const float*)(p->ws + WS_LAML))[g * 128 + pp * 2], li = ((const float*)(p->ws + WS_LAML))[g * 128 + pp * 2 + 1];
    const float* xe = (const float*)(p->ws + WS_XEND) + ((size_t)(g * 1024 + b * NCH)) * 128 + 2 * pp;
    bf16_t* uo = (bf16_t*)(p->ws + WS_U) + ((size_t)(g * 1024 + b * NCH)) * 640 + 512 + 2 * pp;
    float xr = 0.f, xi = 0.f;
    for (int c0 = 0; c0 < NCH; c0 += 8) {
        f32x2 e[8];
#pragma unroll
        for (int j = 0; j < 8; ++j) e[j] = *(const f32x2*)(xe + (size_t)(c0 + j) * 128);
#pragma unroll
        for (int j = 0; j < 8; ++j) { *(unsigned*)(uo + (size_t)(c0 + j) * 640) = cvt_pk_bf16(xr, xi);
            const float nr = lr * xr - li * xi + e[j].x, ni = lr * xi + li * xr + e[j].y; xr = nr; xi = ni; }
    }
}
__device__ __forceinline__ void p3_lru_pass1(KP p, int G, int c) {
    const int ch = threadIdx.x; const float* LA = (const float*)(p->ws + WS_LA); const float* LB = (const float*)(p->ws + WS_LB); float* agg = (float*)(p->ws + WS_AGG);
    for (int it = c; it < B * NCH; it += G) {
        const size_t base = (size_t)it * CH * 512 + ch; float A = 1.f, h = 0.f;
#pragma unroll 8
        for (int t = 0; t < CH; ++t) { const float a = LA[base + (size_t)t * 512], bb = LB[base + (size_t)t * 512]; h = a * h + bb; A *= a; }
        agg[((size_t)it * 2) * 512 + ch] = A; agg[((size_t)it * 2 + 1) * 512 + ch] = h;
    }
}
__device__ __forceinline__ void p4_lru_pass2(KP p, LAS unsigned char* lds, int G, int c) {
    const int ch = threadIdx.x, lane = ch & 63, wave = ch >> 6; LAS float* yb = (LAS float*)lds;
    const float* LA = (const float*)(p->ws + WS_LA); const float* LB = (const float*)(p->ws + WS_LB); const float* agg = (const float*)(p->ws + WS_AGG);
    const bf16_t* GG = (const bf16_t*)(p->ws + WS_GG); bf16_t* YC = (bf16_t*)(p->ws + WS_YCAT);
    for (int it = c; it < B * NCH; it += G) {
        const int b = it >> 6, chunk = it & 63; float h = 0.f;
        for (int cc = 0; cc < chunk; ++cc) { const size_t a0 = ((size_t)(b * NCH + cc) * 2) * 512 + ch; h = agg[a0] * h + agg[a0 + 512]; }
        const size_t base = (size_t)it * CH * 512 + ch;
#pragma unroll 8
        for (int t = 0; t < CH; ++t) { const float a = LA[base + (size_t)t * 512], bb = LB[base + (size_t)t * 512]; h = a * h + bb; yb[t * 512 + ch] = h * bf2f(GG[base + (size_t)t * 512]); }
        __syncthreads();
#pragma unroll
        for (int q = 0; q < 4; ++q) { const int t = wave + 8 * q; const f32x4 v0 = *(LAS f32x4*)(yb + t * 512 + lane * 8), v1 = *(LAS f32x4*)(yb + t * 512 + lane * 8 + 4);
            float s = (v0[0] * v0[0] + v0[1] * v0[1]) + (v0[2] * v0[2] + v0[3] * v0[3]) + (v1[0] * v1[0] + v1[1] * v1[1]) + (v1[2] * v1[2] + v1[3] * v1[3]);
            const float rs = rsqrtf(wave_sum(s) * (1.0f / 512.0f) + 1e-6f);
            *(u32x4*)(YC + ((size_t)it * CH + t) * 1024 + 512 + lane * 8) = pack8(v0 * rs, v1 * rs); }
        __syncthreads();
    }
}
__device__ __forceinline__ void p13_final_ln(KP p, int G, int c) {
    const int lane = threadIdx.x & 63, wave = threadIdx.x >> 6; const float* st3 = (const float*)(p->ws + WS_STATS3);
    for (int row = c * 8 + wave; row < M; row += G * 8) {
        const f32x2 st = *(const f32x2*)(st3 + 2 * (size_t)row); const float mu = st.x * (1.0f / 1024.0f), rstd = rsqrtf(st.y * (1.0f / 1024.0f) - mu * mu + 1e-5f);
        float* o = p->out + (size_t)row * 1024;
#pragma unroll
        for (int j = 0; j < 4; ++j) { const f32x4 v = *(const f32x4*)(o + j * 256 + lane * 4), gg = *(const f32x4*)(p->in[37] + j * 256 + lane * 4), bb = *(const f32x4*)(p->in[38] + j * 256 + lane * 4);
            *(f32x4*)(o + j * 256 + lane * 4) = (v - mu) * rstd * gg + bb; }
    }
}

constexpr int NPHASES = 14;
#ifndef PH_MASK
#define PH_MASK 0x3fff
#endif
__global__ void __launch_bounds__(NTHREADS, 2) mega(Params p_unused) {
    extern __shared__ __attribute__((aligned(16))) unsigned char lds_raw[];
    LAS unsigned char* lds = (LAS unsigned char*)lds_raw;
    const int G = gridDim.x, c = blockIdx.x;
    unsigned char* ws; int lo, hi; { KP p = kargs(); ws = p->ws; lo = p->ph_lo; hi = p->ph_hi; }
#define PH_END(k) if ((k) + 1 < hi) cg::this_grid().sync(); else __syncthreads();
#if (PH_MASK >> 0) & 1
        if (lo <= 0 && 0 < hi) { KP p = kargs(); p0_prep(p, lds, G, c); PH_END(0) }
#endif
#if (PH_MASK >> 1) & 1
        if (lo <= 1 && 1 < hi) { KP p = kargs(); {
            { PlainGeom<1024, 1024, M, DIN, 1024> g; g.A = (const bf16_t*)(ws + WS_H0B); g.Bt = (const bf16_t*)(ws + WS_WIN);
              EpiZ E; E.U = (bf16_t*)(ws + WS_U); E.XL = (bf16_t*)(ws + WS_XL); E.GG = (bf16_t*)(ws + WS_GG); gemm_phase(lds, g, E, G, c); }
            { PlainGeom<1024, 1024, 4096, 1024, 1024> g; g.A = (const bf16_t*)(ws + WS_MEMN); g.Bt = (const bf16_t*)(ws + WS_WK);
              EpiBf16 E; E.O = (bf16_t*)(ws + WS_KMAT); E.ldc = 1024; E.bdiv = 1; E.ob0 = 0; E.ob1 = 0; gemm_phase(lds, g, E, G, c); }
            { PlainGeom<1024, 1024, 1024, 4096, 1024> g; g.A = (const bf16_t*)(ws + WS_WV); g.Bt = (const bf16_t*)(ws + WS_MEMN);
              EpiBf16 E; E.O = (bf16_t*)(ws + WS_VT); E.ldc = 4096; E.bdiv = 1; E.ob0 = 0; E.ob1 = 0; gemm_phase(lds, g, E, G, (c + G - 64) % G); }
        } PH_END(1) }
#endif
#if (PH_MASK >> 2) & 1
        if (lo <= 2 && 2 < hi) { KP p = kargs(); {
            { GeomT<640, 512, 8, 4, 1, NG, 256L * 640, 1024L * 640, 0, 1, 0, 256L * 512, 0, 0> g; g.A = (const bf16_t*)(ws + WS_U); g.Bt = (const bf16_t*)(ws + WS_S5P);
              EpiXend E; E.X = (float*)(ws + WS_XEND); gemm_phase(lds, g, E, G, c); }
            { GeomT<512, 512, 8, 8, 1, 64, 256L * 512, 128, (long)XLROWS * 512, 16, 0, 256L * 512, 0, 1> g; g.A = (const bf16_t*)(ws + WS_XL); g.Bt = (const bf16_t*)(ws + WS_GATES);
              EpiGates E; E.XL = (const bf16_t*)(ws + WS_XL); E.cw = p->in[15]; E.cb = p->in[16]; E.gbias = (const float*)(ws + WS_GBIAS); E.sp8 = (const float*)(ws + WS_SP8);
              E.LA = (float*)(ws + WS_LA); E.LB = (float*)(ws + WS_LB); gemm_phase(lds, g, E, G, (c + G - 128) % G); }
        } PH_END(2) }
#endif
#if (PH_MASK >> 3) & 1
        if (lo <= 3 && 3 < hi) { KP p = kargs(); p3_s5_scan(p, c); p3_lru_pass1(p, G, G - 1 - c); PH_END(3) }
#endif
#if (PH_MASK >> 4) & 1
        if (lo <= 4 && 4 < hi) { KP p = kargs(); {
            { GeomT<640, 640, 10, 4, 2, NG, 256L * 640, 1024L * 640, 0, 1, 256L * 640, 512L * 640, 0, 0> g; g.A = (const bf16_t*)(ws + WS_U); g.Bt = (const bf16_t*)(ws + WS_S5T);
              EpiS5 E; E.U = (const bf16_t*)(ws + WS_U); E.dd = p->in[12]; E.Y1 = (bf16_t*)(ws + WS_Y1); gemm_phase(lds, g, E, G, c); }
            p4_lru_pass2(p, lds, G, c);
        } PH_END(4) }
#endif
#if (PH_MASK >> 5) & 1
        if (lo <= 5 && 5 < hi) { KP p = kargs(); { PlainGeom<512, 512, M, 512, 512> g; g.A = (const bf16_t*)(ws + WS_Y1); g.Bt = (const bf16_t*)(ws + WS_WGLU);
            EpiGlu E; E.Y1 = (const bf16_t*)(ws + WS_Y1); E.bg = p->in[14]; E.YC = (bf16_t*)(ws + WS_YCAT); E.ssq = (float*)(ws + WS_SSQ); gemm_phase(lds, g, E, G, c); } PH_END(5) }
#endif
#if (PH_MASK >> 6) & 1
        if (lo <= 6 && 6 < hi) { KP p = kargs(); { PlainGeom<1024, 1024, M, 1024, 1024> g; g.A = (const bf16_t*)(ws + WS_YCAT); g.Bt = (const bf16_t*)(ws + WS_WMIX);
            EpiRes<0, true, 8> E; E.prev = p->in[0]; E.pstats = (const float*)(ws + WS_STATS0); E.pg = p->in[2]; E.pb_ = p->in[3]; E.vout = (float*)(ws + WS_V1); E.vb = (bf16_t*)(ws + WS_V1B);
            E.ostats = (float*)(ws + WS_STATS1); E.ssq = (const float*)(ws + WS_SSQ); gemm_phase(lds, g, E, G, c); } PH_END(6) }
#endif
#if (PH_MASK >> 7) & 1
        if (lo <= 7 && 7 < hi) { KP p = kargs(); { PlainGeom<1024, 1024, M, 1024, 1024> g; g.A = (const bf16_t*)(ws + WS_V1B); g.Bt = (const bf16_t*)(ws + WS_WQ);
            EpiFold<0> E; E.pstats = (const float*)(ws + WS_STATS1); E.c1 = (const float*)(ws + WS_C1Q); E.c2 = (const float*)(ws + WS_C2Q); E.O = (bf16_t*)(ws + WS_Q); E.ldc = 1024; E.sc = 0.0625f;
            gemm_phase(lds, g, E, G, c); } PH_END(7) }
#endif
#if (PH_MASK >> 8) & 1
        if (lo <= 8 && 8 < hi) { KP p = kargs(); { GeomT<1024, 1024, 4, 8, 1, 64, 256L * 1024, 2048L * 1024, 256, 4, 0, 256L * 1024, 256, 0> g; g.A = (const bf16_t*)(ws + WS_Q); g.Bt = (const bf16_t*)(ws + WS_KMAT);
            EpiSoftmax E; E.P = (bf16_t*)(ws + WS_PROB); gemm_phase(lds, g, E, G, c); } PH_END(8) }
#endif
#if (PH_MASK >> 9) & 1
        if (lo <= 9 && 9 < hi) { KP p = kargs(); { GeomT<256, 4096, 4, 8, 1, 64, 256L * 256, 4L * 2048 * 256, 2048L * 256, 4, 0, 256, 256L * 4096, 0> g; g.A = (const bf16_t*)(ws + WS_PROB); g.Bt = (const bf16_t*)(ws + WS_VT);
            EpiBf16 E; E.O = (bf16_t*)(ws + WS_AO); E.ldc = 1024; E.bdiv = 4; E.ob0 = 2048L * 1024; E.ob1 = 256; gemm_phase(lds, g, E, G, c); } PH_END(9) }
#endif
#if (PH_MASK >> 10) & 1
        if (lo <= 10 && 10 < hi) { KP p = kargs(); { PlainGeom<1024, 1024, M, 1024, 1024> g; g.A = (const bf16_t*)(ws + WS_AO); g.Bt = (const bf16_t*)(ws + WS_WO);
            EpiRes<1, true, -1> E; E.prev = (const float*)(ws + WS_V1); E.pstats = (const float*)(ws + WS_STATS1); E.pg = p->in[25]; E.pb_ = p->in[26]; E.vout = (float*)(ws + WS_V2); E.vb = (bf16_t*)(ws + WS_V1B);
            E.ostats = (float*)(ws + WS_STATS2); E.ssq = nullptr; gemm_phase(lds, g, E, G, c); } PH_END(10) }
#endif
#if (PH_MASK >> 11) & 1
        if (lo <= 11 && 11 < hi) { KP p = kargs(); { PlainGeom<1024, 1024, M, DFF, 1024> g; g.A = (const bf16_t*)(ws + WS_V1B); g.Bt = (const bf16_t*)(ws + WS_WF1);
            EpiFold<1> E; E.pstats = (const float*)(ws + WS_STATS2); E.c1 = (const float*)(ws + WS_C1F); E.c2 = (const float*)(ws + WS_C2F); E.O = (bf16_t*)(ws + WS_HDN); E.ldc = DFF; E.sc = 1.f;
            gemm_phase(lds, g, E, G, c); } PH_END(11) }
#endif
#if (PH_MASK >> 12) & 1
        if (lo <= 12 && 12 < hi) { KP p = kargs(); { PlainGeom<DFF, DFF, M, 1024, DFF> g; g.A = (const bf16_t*)(ws + WS_HDN); g.Bt = (const bf16_t*)(ws + WS_WF2);
            EpiRes<1, false, -1> E; E.prev = (const float*)(ws + WS_V2); E.pstats = (const float*)(ws + WS_STATS2); E.pg = p->in[33]; E.pb_ = p->in[34]; E.vout = p->out; E.vb = nullptr;
            E.ostats = (float*)(ws + WS_STATS3); E.ssq = nullptr; gemm_phase(lds, g, E, G, c); } PH_END(12) }
#endif
#if (PH_MASK >> 13) & 1
        if (lo <= 13 && 13 < hi) { KP p = kargs(); p13_final_ln(p, G, c); PH_END(13) }
#endif
#undef PH_END
}
}
#ifndef MK_MULTI
#define MK_MULTI 0
#endif
#ifndef MK_DEBUG
#define MK_DEBUG 0
#endif
#if MK_DEBUG
namespace dbg {
using namespace fp;
__device__ __forceinline__ float gelu_ref(float x) { const float k = 0.7978845608028654f; float u = k * (x + 0.044715f * x * x * x); return 0.5f * x * (1.0f + tanhf(u)); }
struct CmpArgs { const unsigned char* ws; const float* ref; const float* aux0; const float* aux1; int mode, rows, cols, ldr, bd; float* acc; };
__global__ void __launch_bounds__(256) k_cmp(CmpArgs a) {
    __shared__ float red[8];
    float d2 = 0.f, r2 = 0.f; const size_t n = (size_t)a.rows * a.cols;
    for (size_t i = (size_t)blockIdx.x * 256 + threadIdx.x; i < n; i += (size_t)gridDim.x * 256) {
        const int t = (int)(i / a.cols), c = (int)(i % a.cols); const size_t row = (size_t)a.bd * S + t;
        float f = 0.f, r = a.ref[(size_t)t * a.ldr + c];
        switch (a.mode) {
        case 1: { const int g = c >> 4, hi = c & 15; f = bf2f(((const bf16_t*)(a.ws + WS_U))[((size_t)(g * 1024 + a.bd * NCH + (t >> 5))) * 640 + (t & 31) * 16 + hi]); } break;
        case 2: f = bf2f(((const bf16_t*)(a.ws + WS_XL))[((size_t)(a.bd * XLROWS + 3 + t)) * 512 + c]); break;
        case 3: f = bf2f(((const bf16_t*)(a.ws + WS_GG))[row * 512 + c]); r = gelu_ref(r); break;
        case 4: f = bf2f(((const bf16_t*)(a.ws + WS_KMAT))[((size_t)(a.bd * 256 + t)) * 1024 + c]); break;
        case 5: f = bf2f(((const bf16_t*)(a.ws + WS_VT))[(size_t)c * 4096 + a.bd * 256 + t]); break;
        case 6: f = 1.0f - ((const float*)(a.ws + WS_LA))[row * 512 + c]; r = 1.0f - r; break;
        case 7: f = ((const float*)(a.ws + WS_LB))[row * 512 + c]; break;
        case 8: f = bf2f(((const bf16_t*)(a.ws + WS_Y1))[row * 512 + c]); break;
        case 9: f = bf2f(((const bf16_t*)(a.ws + WS_YCAT))[row * 1024 + 512 + c]) * a.aux0[c]; break;
        case 10: f = bf2f(((const bf16_t*)(a.ws + WS_YCAT))[row * 1024 + c]) * rsqrtf(((const float*)(a.ws + WS_SSQ))[row] * (1.0f / 512.0f) + 1e-6f) * a.aux0[c]; break;
        case 11: { const float* st = (const float*)(a.ws + WS_STATS1) + 2 * row; const float mu = st[0] * (1.0f / 1024.0f), rs = rsqrtf(st[1] * (1.0f / 1024.0f) - mu * mu + 1e-5f);
            f = (((const float*)(a.ws + WS_V1))[row * 1024 + c] - mu) * rs * a.aux0[c] + a.aux1[c]; } break;
        case 12: f = 16.0f * bf2f(((const bf16_t*)(a.ws + WS_Q))[row * 1024 + c]); break;
        case 13: f = bf2f(((const bf16_t*)(a.ws + WS_AO))[row * 1024 + c]); break;
        case 14: { const float* st = (const float*)(a.ws + WS_STATS2) + 2 * row; const float mu = st[0] * (1.0f / 1024.0f), rs = rsqrtf(st[1] * (1.0f / 1024.0f) - mu * mu + 1e-5f);
            f = (((const float*)(a.ws + WS_V2))[row * 1024 + c] - mu) * rs * a.aux0[c] + a.aux1[c]; } break;
        case 15: f = bf2f(((const bf16_t*)(a.ws + WS_HDN))[row * 4096 + c]); break;
        default: break;
        }
        const float d = f - r; d2 += d * d; r2 += r * r;
    }
    for (int o = 32; o > 0; o >>= 1) { d2 += __shfl_xor(d2, o); r2 += __shfl_xor(r2, o); }
    if ((threadIdx.x & 63) == 0) { red[(threadIdx.x >> 6) * 2] = d2; red[(threadIdx.x >> 6) * 2 + 1] = r2; }
    __syncthreads();
    if (threadIdx.x == 0) { atomicAdd(a.acc + a.mode * 2, red[0] + red[2] + red[4] + red[6]); atomicAdd(a.acc + a.mode * 2 + 1, red[1] + red[3] + red[5] + red[7]); }
}
__global__ void k_final(const float* acc, float* out, float tol) {
    if (threadIdx.x != 0 || blockIdx.x != 0) return;
    for (int m = 1; m <= 15; ++m) { const float d = acc[m * 2], r = acc[m * 2 + 1]; const float e = sqrtf(d / fmaxf(r, 1e-30f));
        if (!(e <= tol)) { float k = 1e4f; if (!(e < 0.1f)) k = 1e5f; if (!(e < 1.0f)) k = 1e6f; out[0] = (10.0f + m) * k; return; } }
}
}
#endif

extern "C" void kernel_launch(void* const* d_in, const int* in_sizes, int n_in, void* d_out, int out_size, void* d_ws, size_t ws_size, hipStream_t stream) {
    (void)in_sizes; (void)n_in; (void)out_size;
    static int grid = 0;
    if (grid == 0) {
        int dev = 0, cus = 0, per_cu = 0;
        hipGetDevice(&dev); hipDeviceGetAttribute(&cus, hipDeviceAttributeMultiprocessorCount, dev);
        hipFuncSetAttribute((const void*)fp::mega, hipFuncAttributeMaxDynamicSharedMemorySize, fp::LDS_BYTES);
        hipOccupancyMaxActiveBlocksPerMultiprocessor(&per_cu, (const void*)fp::mega, fp::NTHREADS, fp::LDS_BYTES);
        if (per_cu < 1) { fprintf(stderr, "kernel_launch: occupancy query says %d blocks/CU\n", per_cu); per_cu = 1; }
        grid = cus * 1;
        if (ws_size < fp::WS_END) fprintf(stderr, "kernel_launch: workspace too small: %zu < %zu\n", ws_size, (size_t)fp::WS_END);
        (void)hipGetLastError();
    }
    fp::Params p{};
    for (int i = 0; i < 39; ++i) p.in[i] = (const float*)d_in[i];
    p.out = (float*)d_out; p.ws = (unsigned char*)d_ws;
#if MK_DEBUG
    const int bd = 5;
    float* nws = (float*)d_out;
    float* f1x = nws + nv::naive_floats(1);
    float* acc = (float*)((unsigned char*)d_ws + fp::WS_DBG);
    hipMemsetAsync(acc, 0, 256, stream);
    nv::NaiveBufs NB = nv::run_naive(d_in, nullptr, nws, stream, bd, 1, 9, f1x);
    const float* z = NB.big; const float* xc = z + (size_t)nv::S * 1536; const float* pa = xc + (size_t)nv::S * 512; const float* px = pa + (size_t)nv::S * 512;
    const float* ylru = px + (size_t)nv::S * 512; const float* ys = ylru + (size_t)nv::S * 512; (void)ylru;
    auto cmp = [&](int mode, const float* ref, int rows, int cols, int ldr, const float* a0, const float* a1) {
        dbg::CmpArgs a{(const unsigned char*)d_ws, ref, a0, a1, mode, rows, cols, ldr, bd, acc};
        hipLaunchKernelGGL(dbg::k_cmp, dim3(512), dim3(256), 0, stream, a); };
    auto phase = [&](int ph) { p.ph_lo = ph; p.ph_hi = ph + 1; hipLaunchKernelGGL(fp::mega, dim3(grid), dim3(fp::NTHREADS), fp::LDS_BYTES, stream, p); };
    auto fin = (const float* const*)d_in;
    phase(0); phase(1);
    cmp(1, z, 2048, 512, 1536, nullptr, nullptr); cmp(2, z + 512, 2048, 512, 1536, nullptr, nullptr); cmp(3, z + 1024, 2048, 512, 1536, nullptr, nullptr);
    cmp(4, NB.Km, 256, 1024, 1024, nullptr, nullptr); cmp(5, NB.Vm, 256, 1024, 1024, nullptr, nullptr);
    phase(2);
    cmp(6, pa, 2048, 512, 512, nullptr, nullptr); cmp(7, px, 2048, 512, 512, nullptr, nullptr);
    phase(3); phase(4);
    cmp(8, ys, 2048, 512, 512, nullptr, nullptr); cmp(9, NB.ycat + 512, 2048, 512, 1024, fin[23], nullptr);
    phase(5);
    cmp(10, NB.ycat, 2048, 512, 1024, fin[22], nullptr);
    phase(6);
    cmp(11, NB.h1, 2048, 1024, 1024, fin[25], fin[26]);
    phase(7);
    cmp(12, NB.q, 2048, 1024, 1024, nullptr, nullptr);
    phase(8); phase(9);
    cmp(13, NB.ao, 2048, 1024, 1024, nullptr, nullptr);
    phase(10);
    cmp(14, NB.h2, 2048, 1024, 1024, fin[33], fin[34]);
    phase(11);
    cmp(15, f1x, 2048, 4096, 4096, nullptr, nullptr);
    phase(12); phase(13);
    hipLaunchKernelGGL(dbg::k_final, dim3(1), dim3(64), 0, stream, (const float*)acc, (float*)d_out, 0.03f);
#elif MK_MULTI
    for (int ph = 0; ph < fp::NPHASES; ++ph) { p.ph_lo = ph; p.ph_hi = ph + 1; hipLaunchKernelGGL(fp::mega, dim3(grid), dim3(fp::NTHREADS), fp::LDS_BYTES, stream, p); }
#else
    p.ph_lo = 0; p.ph_hi = fp::NPHASES;
    void* args[] = {&p};
    hipError_t e = hipLaunchCooperativeKernel((const void*)fp::mega, dim3(grid), dim3(fp::NTHREADS), args, fp::LDS_BYTES, stream);
    if (e != hipSuccess) fprintf(stderr, "cooperative launch failed: %s (grid %d)\n", hipGetErrorString(e), grid);
#endif
}
```

```cpp
#include <hip/hip_runtime.h>
#include <cstdio>
#define MK_MULTI 0
#define MK_DEBUG 0
#include <hip/hip_cooperative_groups.h>
namespace cg = cooperative_groups;
namespace fp {
#define LAS __attribute__((address_space(3)))
typedef unsigned short bf16_t;
typedef short bf16x8 __attribute__((ext_vector_type(8)));
typedef float f32x4 __attribute__((ext_vector_type(4)));
typedef float f32x2 __attribute__((ext_vector_type(2)));
typedef unsigned u32x4 __attribute__((ext_vector_type(4)));
typedef unsigned u32x2 __attribute__((ext_vector_type(2)));

constexpr int D = 1024, S = 2048, B = 16, M = B * S, DIN = 1536, DFF = 4096, MEM = 256, NG = 32, CH = 32  , NCH = S / CH  ;
constexpr float ALPHA = 1.189207115002721f;
constexpr int NTHREADS = 512;

constexpr size_t MiB = 1u << 20, KiB = 1u << 10;
constexpr size_t WS_STATS0 = 64 * KiB;
constexpr size_t WS_SSQ = 320 * KiB;
constexpr size_t WS_STATS1 = 448 * KiB;
constexpr size_t WS_STATS2 = 704 * KiB;
constexpr size_t WS_STATS3 = 960 * KiB;
constexpr size_t WS_ZERO_BEG = WS_SSQ, WS_ZERO_END = 1216 * KiB;
constexpr size_t WS_C1Q = 1216 * KiB, WS_C2Q = WS_C1Q + 4096, WS_C1F = WS_C2Q + 4096, WS_C2F = WS_C1F + 16384;
constexpr size_t WS_GBIAS = 1256 * KiB;
constexpr size_t WS_SP8 = 1260 * KiB;
constexpr size_t WS_LAML = 1264 * KiB;
constexpr size_t WS_DBG = 1300 * KiB;
constexpr size_t WS_WIN = 4 * MiB;
constexpr size_t WS_WGLU = 7 * MiB;
constexpr size_t WS_WMIX = WS_WGLU + MiB / 2;
constexpr size_t WS_WQ = WS_WMIX + 2 * MiB, WS_WK = WS_WQ + 2 * MiB, WS_WV = WS_WK + 2 * MiB, WS_WO = WS_WV + 2 * MiB;
constexpr size_t WS_WF1 = WS_WO + 2 * MiB;
constexpr size_t WS_WF2 = WS_WF1 + 8 * MiB;
constexpr size_t WS_S5T = 34 * MiB + MiB / 2;
constexpr size_t WS_S5P = WS_S5T + 20 * MiB;
constexpr size_t WS_GATES = WS_S5P + 8 * MiB;
constexpr size_t WS_V1B = 64 * MiB;
constexpr size_t WS_YCAT = 128 * MiB;
constexpr size_t WS_PROB = 128 * MiB;
constexpr size_t WS_V2 = 128 * MiB;
constexpr size_t WS_KMAT = 192 * MiB;
constexpr size_t WS_VT = 200 * MiB;
constexpr size_t WS_Y1 = 208 * MiB;
constexpr size_t WS_U = 256 * MiB;
constexpr size_t WS_XL = 296 * MiB;
constexpr size_t WS_GG = 330 * MiB;
constexpr size_t WS_XEND = 362 * MiB;
constexpr size_t WS_AGG = 378 * MiB;
constexpr size_t WS_V1 = 256 * MiB;
constexpr size_t WS_H0B = 384 * MiB;
constexpr size_t WS_LA = 384 * MiB;
constexpr size_t WS_AO = 384 * MiB;
constexpr size_t WS_MEMN = 448 * MiB;
constexpr size_t WS_LB = 448 * MiB;
constexpr size_t WS_Q = 448 * MiB;
constexpr size_t WS_HDN = 256 * MiB;
constexpr size_t WS_END = 512 * MiB;
constexpr int XLROWS = S + 3;

constexpr int LDS_STAGE = 131072, LDS_X = LDS_STAGE  , LDS_BARW = LDS_STAGE + 8192  , LDS_BYTES = 147456;

__device__ __forceinline__ unsigned cvt_pk_bf16(float lo, float hi) { unsigned r; asm volatile("v_cvt_pk_bf16_f32 %0, %1, %2" : "=v"(r) : "v"(lo), "v"(hi)); return r; }
__device__ __forceinline__ bf16_t f2bf(float f) { return (bf16_t)(cvt_pk_bf16(f, 0.f) & 0xffffu); }
__device__ __forceinline__ float bf2f(unsigned short b) { return __uint_as_float(((unsigned)b) << 16); }
__device__ __forceinline__ float bflo(unsigned w) { return __uint_as_float(w << 16); }
__device__ __forceinline__ float bfhi(unsigned w) { return __uint_as_float(w & 0xffff0000u); }
__device__ __forceinline__ u32x4 pack8(f32x4 a, f32x4 b) { u32x4 w; w.x = cvt_pk_bf16(a[0], a[1]); w.y = cvt_pk_bf16(a[2], a[3]); w.z = cvt_pk_bf16(b[0], b[1]); w.w = cvt_pk_bf16(b[2], b[3]); return w; }
__device__ __forceinline__ void unpack8(u32x4 w, f32x4& a, f32x4& b) { a[0] = bflo(w.x); a[1] = bfhi(w.x); a[2] = bflo(w.y); a[3] = bfhi(w.y); b[0] = bflo(w.z); b[1] = bfhi(w.z); b[2] = bflo(w.w); b[3] = bfhi(w.w); }
__device__ __forceinline__ float fast_exp(float x) { return __builtin_amdgcn_exp2f(x * 1.4426950408889634f); }
__device__ __forceinline__ float fast_rcp(float x) { return __builtin_amdgcn_rcpf(x); }
__device__ __forceinline__ float sigm(float x) { return fast_rcp(1.0f + fast_exp(-x)); }
__device__ __forceinline__ float gelu_t(float x) {
    const float u = 0.7978845608028654f * (x + 0.044715f * x * x * x);
    return x * sigm(2.0f * u);
}
__device__ __forceinline__ float wave_sum(float v) {
#pragma unroll
    for (int o = 32; o > 0; o >>= 1) v += __shfl_xor(v, o);
    return v;
}


#define XB_TMO      128
#define XB_XCNT(j)  (256  + 64 * (j))
#define XB_XSUB(j)  (1280 + 64 * (j))
#define XB_XGEN(j)  (2304 + 64 * (j))
#define XB_TOP      3328
#define XB_TOPGEN   3392
#define XCD_BAR_WORDS 3456
#define XB_SPIN_CAP (1u << 18)
__device__ __forceinline__ unsigned xb_ld(unsigned* p)              { return __hip_atomic_load(p, __ATOMIC_RELAXED, __HIP_MEMORY_SCOPE_AGENT); }
__device__ __forceinline__ unsigned xb_add(unsigned* p, unsigned v) { return __hip_atomic_fetch_add(p, v, __ATOMIC_RELAXED, __HIP_MEMORY_SCOPE_AGENT); }
__device__ __forceinline__ unsigned xb_xcc_id() { return (unsigned)__builtin_amdgcn_s_getreg((3 << 11) | 20) & 0xFu; }
#define XB_SPIN(cond, bar) do { unsigned _sp = 0; while (cond) { __builtin_amdgcn_s_sleep(1); \
    if ((++_sp & 255u) == 0u) { if (xb_ld(&(bar)[XB_TMO])) break; if (_sp > XB_SPIN_CAP) { atomicAdd(&(bar)[XB_TMO], 1u); break; } } } } while (0)
struct XcdBarrier { unsigned* bar; unsigned x; volatile LAS unsigned* st; };
__device__ __forceinline__ XcdBarrier xcd_barrier_post(unsigned* bar, volatile LAS unsigned* st) {
    XcdBarrier b; b.bar = bar; b.x = xb_xcc_id(); b.st = st;
    if (threadIdx.x == 0) (void)xb_add(&bar[XB_XCNT(b.x)], 1u);
    return b;
}
__device__ __forceinline__ void xcd_barrier_complete(unsigned* bar, unsigned x, unsigned& nloc, unsigned& nx) {
    const unsigned G = gridDim.x * gridDim.y * gridDim.z;
    unsigned sum, cnt, mine, sp = 0u;
    for (;;) {
        sum = 0u; cnt = 0u; mine = 0u;
#pragma unroll
        for (unsigned j = 0; j < 16; ++j) { const unsigned c = xb_ld(&bar[XB_XCNT(j)]); sum += c; cnt += (c > 0u) ? 1u : 0u; mine = (j == x) ? c : mine; }
        if (sum == G) break;
        __builtin_amdgcn_s_sleep(1);
        if ((++sp & 255u) == 0u) { if (xb_ld(&bar[XB_TMO])) break; if (sp > XB_SPIN_CAP) { atomicAdd(&bar[XB_TMO], 1u); break; } }
    }
    nloc = mine > 0u ? mine : 1u; nx = cnt > 0u ? cnt : 1u;
}
__device__ __forceinline__ void xcd_barrier(const XcdBarrier& b) {
    asm volatile("s_waitcnt vmcnt(0)" ::: "memory");
    __syncthreads();
    if (threadIdx.x == 0) {
        unsigned* bar = b.bar;
        __builtin_amdgcn_s_waitcnt(0);
        unsigned nloc = b.st[0], nx = b.st[1];
        if (nloc == 0u) { xcd_barrier_complete(bar, b.x, nloc, nx); b.st[0] = nloc; b.st[1] = nx; }
        const unsigned old = xb_add(&bar[XB_XSUB(b.x)], 1u);
        const unsigned gen = old / nloc;
        if (old + 1u == (gen + 1u) * nloc) {
            __builtin_amdgcn_fence(__ATOMIC_RELEASE, "agent");
            asm volatile("s_waitcnt vmcnt(0)" ::: "memory");
            const unsigned og = xb_add(&bar[XB_TOP], 1u);
            const unsigned tg = og / nx;
            if (og + 1u == (tg + 1u) * nx) xb_add(&bar[XB_TOPGEN], 1u);
            else XB_SPIN(xb_ld(&bar[XB_TOPGEN]) == tg, bar);
            __builtin_amdgcn_fence(__ATOMIC_ACQUIRE, "agent");
            xb_add(&bar[XB_XGEN(b.x)], 1u);
            asm volatile("s_waitcnt vmcnt(0)" ::: "memory");
        } else {
            XB_SPIN(xb_ld(&bar[XB_XGEN(b.x)]) == gen, bar);
            __builtin_amdgcn_fence(__ATOMIC_ACQUIRE, "agent");
            asm volatile("s_waitcnt vmcnt(0)" ::: "memory");
        }
    }
    __syncthreads();
}

constexpr int BM = 256, BK = 64, HALF = 128, HTB = HALF * BK * 2, NXCD = 8, WGM = 8;
__device__ __forceinline__ int lds_byte(int r, int c) { const int st = (r >> 4) * 2 + (c >> 5), rr = r & 15, cc = c & 31, ob = rr * 64 + cc * 2; return st * 1024 + (ob ^ (((ob >> 9) & 1) << 5)); }
__device__ __forceinline__ void stage_rc(int b, int& R, int& C) { const int st = b / 1024, sb = b % 1024, swz = sb ^ (((sb >> 9) & 1) << 5); R = (st >> 1) * 16 + swz / 64; C = (st & 1) * 32 + (swz % 64) / 2; }
__device__ __forceinline__ int perm32(int rho) { const int n = rho >> 4, i = rho & 15; return 8 * (i >> 2) + 4 * n + (i & 3); }

struct Unit { int pm, pn, pb; };
template <int LDA, int LDB, int NT, int NM, int NN, int NB, long SAM, long SAB0, long SAB1, int BDIV, long SBN, long SBB0, long SBB1, int CONV>
struct GeomT {
    const bf16_t* A; const bf16_t* Bt;
    static constexpr int lda = LDA, ldb = LDB, nt = NT;
    static constexpr int nwg = NM * NN * NB;
    __device__ __forceinline__ bool next(int i, int G, int c, Unit& u) const {
        const int L = i * G + c; if (L >= nwg) return false;
        int wgid = L; { constexpr int q = nwg / NXCD, r = nwg % NXCD; const int xcd = wgid % NXCD, off = wgid / NXCD; wgid = (xcd < r ? xcd * (q + 1) : r * (q + 1) + (xcd - r) * q) + off; }
        constexpr int per = NM * NN; u.pb = wgid / per; const int w = wgid % per;
        constexpr int nig = WGM * NN; const int gid = w / nig, fm = gid * WGM, gsz = (NM - fm) < WGM ? (NM - fm) : WGM;
        u.pm = fm + ((w % nig) % gsz); u.pn = (w % nig) / gsz; return true;
    }
    __device__ __forceinline__ const char* abase(const Unit& u) const { return (const char*)(A + (long)u.pm * SAM + (long)(u.pb / BDIV) * SAB0 + (long)(u.pb % BDIV) * SAB1); }
    __device__ __forceinline__ const char* bbase(const Unit& u) const { return (const char*)(Bt + (long)u.pn * SBN + (long)(u.pb / BDIV) * SBB0 + (long)(u.pb % BDIV) * SBB1); }
    static __device__ __forceinline__ size_t koffA(int t) { return CONV ? ((size_t)(t >> 1) * (size_t)LDA * 2 + (size_t)(t & 1) * 128) : (size_t)t * 128; }
    static __device__ __forceinline__ size_t koffB(int t) { return (size_t)t * 128; }
};
template <int LDA, int LDB, int Mr, int Nc, int K> using PlainGeom = GeomT<LDA, LDB, K / 64, Mr / 256, Nc / 256, 1, 256L * LDA, 0, 0, 1, 256L * LDB, 0, 0, 0>;

template <class Geom, class Epi>
__device__ __forceinline__ void gemm_phase(LAS unsigned char* lds, const Geom g, const Epi& E, const int G, const int c) {
    const int tid = threadIdx.x, wid = __builtin_amdgcn_readfirstlane(tid >> 6), lane = tid & 63, wr = wid >> 2, wc = wid & 3, fr = lane & 15, fq = lane >> 4;
    constexpr int nt = Geom::nt;
    unsigned voffA[2], voffB[2];
#pragma unroll
    for (int i = 0; i < 2; ++i) { int R, C; stage_rc(tid * 16 + i * 8192, R, C); const int Rb = (R & ~31) + perm32(R & 31);
        voffA[i] = (unsigned)(R * Geom::lda + C) * 2u; voffB[i] = (unsigned)(Rb * Geom::ldb + C) * 2u; }
    constexpr size_t hstepA = (size_t)HALF * Geom::lda * 2, hstepB = (size_t)HALF * Geom::ldb * 2;
    const unsigned ldsw = (unsigned)wid * 1024u;
    const int aoff = lds_byte(wr * 64 + fr, fq * 8), boff = lds_byte(wc * 32 + fr, fq * 8);
#define PG8_SA(b, h) (((b) * 2 + (h)) * HTB)
#define PG8_SB(b, h) ((4 + (b) * 2 + (h)) * HTB)
#define PG8_STAGE(bufoff, gbase, voff) do { _Pragma("unroll") for (int _i = 0; _i < 2; ++_i) \
        __builtin_amdgcn_global_load_lds((const unsigned*)((const char*)(gbase) + (voff)[_i]), (LAS unsigned*)(lds + (bufoff) + ldsw + _i * 8192), 16, 0, 0); } while (0)
#define PG8_LDA(dst, b, h) do { _Pragma("unroll") for (int m = 0; m < 4; ++m) _Pragma("unroll") for (int k = 0; k < 2; ++k) dst[m][k] = *(const LAS bf16x8*)(lds + PG8_SA(b, h) + aoff + m * 2048 + k * 1024); } while (0)
#define PG8_LDB(dst, b, h) do { _Pragma("unroll") for (int n = 0; n < 2; ++n) _Pragma("unroll") for (int k = 0; k < 2; ++k) dst[n][k] = *(const LAS bf16x8*)(lds + PG8_SB(b, h) + boff + n * 2048 + k * 1024); } while (0)
#define PG8_MMA(ai, bj, At, Bt) do { __builtin_amdgcn_s_setprio(1); _Pragma("unroll") for (int m = 0; m < 4; ++m) _Pragma("unroll") for (int n = 0; n < 2; ++n) _Pragma("unroll") for (int k = 0; k < 2; ++k) \
        acc[ai][bj][m][n] = __builtin_amdgcn_mfma_f32_16x16x32_bf16(Bt[n][k], At[m][k], acc[ai][bj][m][n], 0, 0, 0); __builtin_amdgcn_s_setprio(0); } while (0)
#define PG8_WAIT_V(n) asm volatile("s_waitcnt vmcnt(" #n ")" ::: "memory")
#define PG8_WAIT_L(n) asm volatile("s_waitcnt lgkmcnt(" #n ")" ::: "memory")
#define PG8_BAR __builtin_amdgcn_s_barrier()
#define PG8_SCHED __builtin_amdgcn_sched_barrier(0)
    Unit cur, nxt; int ui = 0;
    if (!g.next(0, G, c, cur)) return;
    f32x4 acc[2][2][4][2];
#pragma unroll
    for (int a = 0; a < 2; ++a)
#pragma unroll
        for (int b = 0; b < 2; ++b)
#pragma unroll
            for (int m = 0; m < 4; ++m)
#pragma unroll
                for (int n = 0; n < 2; ++n) acc[a][b][m][n] = (f32x4){0.f, 0.f, 0.f, 0.f};
    bf16x8 At[4][2], B0[2][2], B1[2][2];
    const char* cA = g.abase(cur); const char* cB = g.bbase(cur);
    PG8_STAGE(PG8_SB(0, 0), cB, voffB); PG8_STAGE(PG8_SB(0, 1), cB + hstepB, voffB); PG8_STAGE(PG8_SA(0, 0), cA, voffA); PG8_STAGE(PG8_SA(0, 1), cA + hstepA, voffA);
    if (wr == 1) PG8_BAR;
    PG8_WAIT_V(2); PG8_BAR;
    PG8_STAGE(PG8_SB(1, 0), cB + g.koffB(1), voffB); PG8_STAGE(PG8_SA(1, 0), cA + g.koffA(1), voffA); PG8_STAGE(PG8_SB(1, 1), cB + hstepB + g.koffB(1), voffB);
    PG8_WAIT_V(6); PG8_BAR;
    for (;;) {
        const bool has_next = g.next(ui + 1, G, c, nxt);
        const char* nA = has_next ? g.abase(nxt) : cA; const char* nB = has_next ? g.bbase(nxt) : cB;
#pragma nounroll
        for (int t = 0; t < nt; t += 2) {
            const bool last = (t == nt - 2);
            const char* a1 = cA + g.koffA(t + 1);
            const char* a2 = last ? nA : cA + g.koffA(t + 2); const char* b2 = last ? nB : cB + g.koffB(t + 2);
            const char* a3 = last ? nA + g.koffA(1) : cA + g.koffA(t + 3); const char* b3 = last ? nB + g.koffB(1) : cB + g.koffB(t + 3);
            if constexpr (Epi::MIDK >= 0) { if (t == Epi::MIDK) E.midk(acc, cur, wr, wc, fr, fq); }
            PG8_LDB(B0, 0, 0); PG8_LDB(B1, 0, 1); PG8_SCHED; PG8_LDA(At, 0, 0); PG8_STAGE(PG8_SA(1, 1), a1 + hstepA, voffA);
            PG8_WAIT_V(8); PG8_WAIT_L(0); PG8_BAR; PG8_MMA(0, 0, At, B0); PG8_MMA(0, 1, At, B1); PG8_BAR; PG8_SCHED;
            PG8_LDA(At, 0, 1); PG8_STAGE(PG8_SB(0, 0), b2, voffB); PG8_STAGE(PG8_SB(0, 1), b2 + hstepB, voffB); PG8_STAGE(PG8_SA(0, 0), a2, voffA);
            PG8_WAIT_V(8); PG8_WAIT_L(0); PG8_BAR; PG8_MMA(1, 0, At, B0); PG8_MMA(1, 1, At, B1); PG8_BAR; PG8_SCHED;
            PG8_LDB(B0, 1, 0); PG8_LDB(B1, 1, 1); PG8_SCHED; PG8_LDA(At, 1, 0); PG8_STAGE(PG8_SA(0, 1), a2 + hstepA, voffA);
            PG8_WAIT_V(8); PG8_WAIT_L(0); PG8_BAR; PG8_MMA(0, 0, At, B0); PG8_MMA(0, 1, At, B1); PG8_BAR; PG8_SCHED;
            PG8_LDA(At, 1, 1); PG8_STAGE(PG8_SB(1, 0), b3, voffB); PG8_STAGE(PG8_SB(1, 1), b3 + hstepB, voffB); PG8_STAGE(PG8_SA(1, 0), a3, voffA);
            PG8_WAIT_V(8); PG8_WAIT_L(0); PG8_BAR; PG8_MMA(1, 0, At, B0); PG8_MMA(1, 1, At, B1); PG8_BAR; PG8_SCHED;
        }
        if (wr == 0) PG8_BAR;
        E(acc, cur, wr, wc, fr, fq, lds);
        if (!has_next) break;
#pragma unroll
        for (int a = 0; a < 2; ++a)
#pragma unroll
            for (int b = 0; b < 2; ++b)
#pragma unroll
                for (int m = 0; m < 4; ++m)
#pragma unroll
                    for (int n = 0; n < 2; ++n) acc[a][b][m][n] = (f32x4){0.f, 0.f, 0.f, 0.f};
        cur = nxt; cA = nA; cB = nB; ++ui;
        if (wr == 1) PG8_BAR;
    }
    PG8_WAIT_V(0);
    PG8_BAR;
#undef PG8_SA
#undef PG8_SB
#undef PG8_STAGE
#undef PG8_LDA
#undef PG8_LDB
#undef PG8_MMA
#undef PG8_WAIT_V
#undef PG8_WAIT_L
#undef PG8_BAR
#undef PG8_SCHED
}
#define EPI_ARGS f32x4 (&acc)[2][2][4][2], const Unit& u, int wr, int wc, int fr, int fq
struct EpiBase { static constexpr int MIDK = -1; __device__ __forceinline__ void midk(EPI_ARGS) const {} };

struct EpiZ : EpiBase {
    bf16_t* U; bf16_t* XL; bf16_t* GG;
    __device__ __forceinline__ void operator()(EPI_ARGS, LAS unsigned char*) const {
        const int row0 = u.pm * BM + wr * 64 + fr;
#pragma unroll
        for (int ai = 0; ai < 2; ++ai)
#pragma unroll
            for (int m = 0; m < 4; ++m) {
                const int r = row0 + ai * HALF + m * 16, b = r >> 11, t = r & 2047;
#pragma unroll
                for (int bj = 0; bj < 2; ++bj) {
                    const int c = u.pn * BM + bj * HALF + wc * 32 + fq * 8;
                    f32x4 v0 = acc[ai][bj][m][0], v1 = acc[ai][bj][m][1];
                    if (u.pn < 2) {
                        const int g = c >> 4, hi0 = c & 15;
                        *(u32x4*)(U + ((size_t)(g * 1024 + b * NCH + (t >> 5)) * 640 + (t & 31) * 16 + hi0)) = pack8(v0, v1);
                    } else if (u.pn < 4) {
                        *(u32x4*)(XL + ((size_t)(b * XLROWS + 3 + t) * 512 + (c - 512))) = pack8(v0, v1);
                    } else {
#pragma unroll
                        for (int j = 0; j < 4; ++j) { v0[j] = gelu_t(v0[j]); v1[j] = gelu_t(v1[j]); }
                        *(u32x4*)(GG + ((size_t)r * 512 + (c - 1024))) = pack8(v0, v1);
                    }
                }
                asm volatile("" ::: "memory");
            }
    }
};
struct EpiBf16 : EpiBase {
    bf16_t* O; int ldc; int bdiv; long ob0, ob1;
    __device__ __forceinline__ void operator()(EPI_ARGS, LAS unsigned char*) const {
        bf16_t* base = O + (long)(u.pb / bdiv) * ob0 + (long)(u.pb % bdiv) * ob1;
        const int row0 = u.pm * BM + wr * 64 + fr;
#pragma unroll
        for (int ai = 0; ai < 2; ++ai)
#pragma unroll
            for (int m = 0; m < 4; ++m) {
                bf16_t* rowp = base + (size_t)(row0 + ai * HALF + m * 16) * ldc + u.pn * BM + wc * 32 + fq * 8;
#pragma unroll
                for (int bj = 0; bj < 2; ++bj) *(u32x4*)(rowp + bj * HALF) = pack8(acc[ai][bj][m][0], acc[ai][bj][m][1]);
            }
    }
};
struct EpiXend : EpiBase {
    float* X;
    __device__ __forceinline__ void operator()(EPI_ARGS, LAS unsigned char*) const {
        const int row0 = u.pm * BM + wr * 64 + fr;
#pragma unroll
        for (int ai = 0; ai < 2; ++ai)
#pragma unroll
            for (int m = 0; m < 4; ++m) {
                float* rowp = X + ((size_t)u.pb * 1024 + row0 + ai * HALF + m * 16) * 128 + wc * 32 + fq * 8;
                *(f32x4*)(rowp) = acc[ai][0][m][0]; *(f32x4*)(rowp + 4) = acc[ai][0][m][1];
            }
    }
};
struct EpiGates : EpiBase {
    const bf16_t* XL; const float* cw; const float* cb; const float* gbias; const float* sp8; float* LA; float* LB;
    __device__ __forceinline__ void operator()(EPI_ARGS, LAS unsigned char*) const {
        const int hp = u.pb >> 4, b = u.pb & 15, rt = u.pm;
        const int ch0 = hp * 128 + wc * 32 + fq * 8;
        const float* gb = gbias + hp * 256 + wc * 32 + fq * 8;
#pragma unroll
        for (int ai = 0; ai < 2; ++ai)
#pragma unroll
            for (int m = 0; m < 4; ++m) {
                const int t = rt * 256 + ai * HALF + wr * 64 + m * 16 + fr;
                const bf16_t* xr = XL + ((size_t)(b * XLROWS + t) * 512 + ch0);
                const size_t o = ((size_t)(b * S + t)) * 512 + ch0;
#pragma unroll
                for (int n = 0; n < 2; ++n) {
                    f32x4 xc = *(const f32x4*)(cb + ch0 + 4 * n);
#pragma unroll
                    for (int k = 0; k < 4; ++k) { const u32x2 wv = *(const u32x2*)(xr + (size_t)k * 512 + 4 * n); const f32x4 w = *(const f32x4*)(cw + k * 512 + ch0 + 4 * n);
                        xc[0] += w[0] * bflo(wv.x); xc[1] += w[1] * bfhi(wv.x); xc[2] += w[2] * bflo(wv.y); xc[3] += w[3] * bfhi(wv.y); }
                    const f32x4 ba = *(const f32x4*)(gb + 4 * n), bx = *(const f32x4*)(gb + 128 + 4 * n), spv = *(const f32x4*)(sp8 + ch0 + 4 * n);
                    f32x4 av, bv;
#pragma unroll
                    for (int j = 0; j < 4; ++j) {
                        const float r = sigm(acc[ai][0][m][n][j] + ba[j]), ig = sigm(acc[ai][1][m][n][j] + bx[j]);
                        const float la = -r * spv[j];
                        const float a = fast_exp(la);
                        const float x2 = 2.0f * la;
                        const float om = (x2 > -0.1f) ? (-x2 * (1.0f + x2 * (0.5f + x2 * (0.16666667f + x2 * 0.041666668f)))) : (1.0f - a * a);
                        av[j] = a; bv[j] = __builtin_sqrtf(om) * ig * xc[j];
                    }
                    *(f32x4*)(LA + o + 4 * n) = av; *(f32x4*)(LB + o + 4 * n) = bv;
                    asm volatile("" ::: "memory");
                }
            }
    }
};
struct EpiS5 : EpiBase {
    const bf16_t* U; const float* dd; bf16_t* Y1;
    __device__ __forceinline__ void operator()(EPI_ARGS, LAS unsigned char*) const {
        const int g = u.pb; const int row0 = u.pm * BM + wr * 64 + fr;
#pragma unroll
        for (int bj = 0; bj < 2; ++bj) {
            const int c = u.pn * BM + bj * HALF + wc * 32 + fq * 8, i = c >> 4, ho0 = c & 15;
            const f32x4 d0 = *(const f32x4*)(dd + g * 16 + ho0), d1 = *(const f32x4*)(dd + g * 16 + ho0 + 4);
#pragma unroll
            for (int ai = 0; ai < 2; ++ai)
#pragma unroll
                for (int m = 0; m < 4; ++m) {
                    const int R = row0 + ai * HALF + m * 16, b = R >> 6, chn = R & 63;
                    const u32x4 uw = *(const u32x4*)(U + ((size_t)(g * 1024 + R) * 640 + c)); f32x4 u0, u1; unpack8(uw, u0, u1);
                    f32x4 v0 = acc[ai][bj][m][0] + d0 * u0, v1 = acc[ai][bj][m][1] + d1 * u1;
#pragma unroll
                    for (int j = 0; j < 4; ++j) { v0[j] = gelu_t(v0[j]); v1[j] = gelu_t(v1[j]); }
                    *(u32x4*)(Y1 + ((size_t)(b * S + chn * CH + i) * 512 + g * 16 + ho0)) = pack8(v0, v1);
                    asm volatile("" ::: "memory");
                }
        }
    }
};
struct EpiGlu : EpiBase {
    const bf16_t* Y1; const float* bg; bf16_t* YC; float* ssq;
    __device__ __forceinline__ void operator()(EPI_ARGS, LAS unsigned char*) const {
        const int row0 = u.pm * BM + wr * 64 + fr;
        float ss[2][4];
#pragma unroll
        for (int ai = 0; ai < 2; ++ai)
#pragma unroll
            for (int m = 0; m < 4; ++m) ss[ai][m] = 0.f;
#pragma unroll
        for (int bj = 0; bj < 2; ++bj) {
            const int c = u.pn * BM + bj * HALF + wc * 32 + fq * 8;
            const f32x4 g0 = *(const f32x4*)(bg + c), g1 = *(const f32x4*)(bg + c + 4);
#pragma unroll
            for (int ai = 0; ai < 2; ++ai)
#pragma unroll
                for (int m = 0; m < 4; ++m) {
                    const size_t r = row0 + ai * HALF + m * 16;
                    const u32x4 yw = *(const u32x4*)(Y1 + r * 512 + c); f32x4 y0, y1; unpack8(yw, y0, y1);
                    f32x4 v0, v1;
#pragma unroll
                    for (int j = 0; j < 4; ++j) { v0[j] = y0[j] * sigm(acc[ai][bj][m][0][j] + g0[j]); v1[j] = y1[j] * sigm(acc[ai][bj][m][1][j] + g1[j]); ss[ai][m] += v0[j] * v0[j] + v1[j] * v1[j]; }
                    *(u32x4*)(YC + r * 1024 + c) = pack8(v0, v1);
                    asm volatile("" ::: "memory");
                }
        }
#pragma unroll
        for (int ai = 0; ai < 2; ++ai)
#pragma unroll
            for (int m = 0; m < 4; ++m) { float s = ss[ai][m]; s += __shfl_xor(s, 16); s += __shfl_xor(s, 32); if (fq == 0) atomicAdd(ssq + row0 + ai * HALF + m * 16, s); }
    }
};
template <int MODE, bool HASB, int MK>
struct EpiRes {
    static constexpr int MIDK = MK;
    const float* prev; const float* pstats; const float* pg; const float* pb_; float* vout; bf16_t* vb; float* ostats; const float* ssq;
    __device__ __forceinline__ void midk(EPI_ARGS) const {
        const int row0 = u.pm * BM + wr * 64 + fr;
#pragma unroll
        for (int ai = 0; ai < 2; ++ai)
#pragma unroll
            for (int m = 0; m < 4; ++m) { const float s = __builtin_amdgcn_rsqf(ssq[row0 + ai * HALF + m * 16] * (1.0f / 512.0f) + 1e-6f);
#pragma unroll
                for (int bj = 0; bj < 2; ++bj)
#pragma unroll
                    for (int n = 0; n < 2; ++n) acc[ai][bj][m][n] = acc[ai][bj][m][n] * s; }
    }
    __device__ __forceinline__ void operator()(EPI_ARGS, LAS unsigned char*) const {
        const int row0 = u.pm * BM + wr * 64 + fr;
        float s1[2][4], s2[2][4];
#pragma unroll
        for (int ai = 0; ai < 2; ++ai)
#pragma unroll
            for (int m = 0; m < 4; ++m) { s1[ai][m] = 0.f; s2[ai][m] = 0.f; }
#pragma unroll
        for (int bj = 0; bj < 2; ++bj) {
            const int c = u.pn * BM + bj * HALF + wc * 32 + fq * 8;
            const f32x4 g0 = *(const f32x4*)(pg + c), g1 = *(const f32x4*)(pg + c + 4), b0 = *(const f32x4*)(pb_ + c), b1 = *(const f32x4*)(pb_ + c + 4);
#pragma unroll
            for (int ai = 0; ai < 2; ++ai)
#pragma unroll
                for (int m = 0; m < 4; ++m) {
                    const int r = row0 + ai * HALF + m * 16;
                    const f32x2 st = *(const f32x2*)(pstats + 2 * (size_t)r);
                    float mm, rr;
                    if (MODE == 0) { mm = st.x; rr = st.y; }
                    else { mm = st.x * (1.0f / 1024.0f); rr = __builtin_amdgcn_rsqf(st.y * (1.0f / 1024.0f) - mm * mm + 1e-5f); }
                    const size_t o = (size_t)r * 1024 + c;
                    const f32x4 p0 = *(const f32x4*)(prev + o), p1 = *(const f32x4*)(prev + o + 4);
                    const f32x4 v0 = ((p0 - mm) * rr * g0 + b0) * ALPHA + acc[ai][bj][m][0], v1 = ((p1 - mm) * rr * g1 + b1) * ALPHA + acc[ai][bj][m][1];
                    *(f32x4*)(vout + o) = v0; *(f32x4*)(vout + o + 4) = v1;
                    if (HASB) *(u32x4*)(vb + o) = pack8(v0, v1);
#pragma unroll
                    for (int j = 0; j < 4; ++j) { s1[ai][m] += v0[j] + v1[j]; s2[ai][m] += v0[j] * v0[j] + v1[j] * v1[j]; }
                    asm volatile("" ::: "memory");
                }
        }
#pragma unroll
        for (int ai = 0; ai < 2; ++ai)
#pragma unroll
            for (int m = 0; m < 4; ++m) { float a = s1[ai][m], q = s2[ai][m]; a += __shfl_xor(a, 16); a += __shfl_xor(a, 32); q += __shfl_xor(q, 16); q += __shfl_xor(q, 32);
                if (fq == 0) { float* d = ostats + 2 * (size_t)(row0 + ai * HALF + m * 16); atomicAdd(d, a); atomicAdd(d + 1, q); } }
    }
};
template <int ACT>
struct EpiFold : EpiBase {
    const float* pstats; const float* c1; const float* c2; bf16_t* O; int ldc; float sc;
    __device__ __forceinline__ void operator()(EPI_ARGS, LAS unsigned char*) const {
        const int row0 = u.pm * BM + wr * 64 + fr;
        float mu[2][4], rs[2][4];
#pragma unroll
        for (int ai = 0; ai < 2; ++ai)
#pragma unroll
            for (int m = 0; m < 4; ++m) { const f32x2 st = *(const f32x2*)(pstats + 2 * (size_t)(row0 + ai * HALF + m * 16));
                const float mm = st.x * (1.0f / 1024.0f); mu[ai][m] = mm; rs[ai][m] = __builtin_amdgcn_rsqf(st.y * (1.0f / 1024.0f) - mm * mm + 1e-5f); }
#pragma unroll
        for (int bj = 0; bj < 2; ++bj) {
            const int c = u.pn * BM + bj * HALF + wc * 32 + fq * 8;
            const f32x4 k0 = *(const f32x4*)(c1 + c), k1 = *(const f32x4*)(c1 + c + 4), e0 = *(const f32x4*)(c2 + c), e1 = *(const f32x4*)(c2 + c + 4);
#pragma unroll
            for (int ai = 0; ai < 2; ++ai)
#pragma unroll
                for (int m = 0; m < 4; ++m) {
                    const float mm = mu[ai][m], rr = rs[ai][m];
                    f32x4 v0 = (acc[ai][bj][m][0] - k0 * mm) * rr + e0, v1 = (acc[ai][bj][m][1] - k1 * mm) * rr + e1;
                    if (ACT == 0) { v0 = v0 * sc; v1 = v1 * sc; }
                    else {
#pragma unroll
                        for (int j = 0; j < 4; ++j) { const float a = fmaxf(v0[j], 0.f), b = fmaxf(v1[j], 0.f); v0[j] = a * a; v1[j] = b * b; } }
                    *(u32x4*)(O + (size_t)(row0 + ai * HALF + m * 16) * ldc + c) = pack8(v0, v1);
                    asm volatile("" ::: "memory");
                }
        }
    }
};
struct EpiSoftmax : EpiBase {
    bf16_t* P;
    __device__ __forceinline__ void operator()(EPI_ARGS, LAS unsigned char* lds) const {
        LAS f32x2* X = (LAS f32x2*)(lds + LDS_X);
        float mw[2][4];
#pragma unroll
        for (int ai = 0; ai < 2; ++ai)
#pragma unroll
            for (int m = 0; m < 4; ++m) {
                float mx = -3.0e38f;
#pragma unroll
                for (int bj = 0; bj < 2; ++bj)
#pragma unroll
                    for (int n = 0; n < 2; ++n)
#pragma unroll
                        for (int j = 0; j < 4; ++j) mx = fmaxf(mx, acc[ai][bj][m][n][j]);
                mx = fmaxf(mx, __shfl_xor(mx, 16)); mx = fmaxf(mx, __shfl_xor(mx, 32));
                float sm = 0.f;
#pragma unroll
                for (int bj = 0; bj < 2; ++bj)
#pragma unroll
                    for (int n = 0; n < 2; ++n)
#pragma unroll
                        for (int j = 0; j < 4; ++j) { const float e = fast_exp(acc[ai][bj][m][n][j] - mx); acc[ai][bj][m][n][j] = e; sm += e; }
                sm += __shfl_xor(sm, 16); sm += __shfl_xor(sm, 32);
                mw[ai][m] = mx;
                if (fq == 0) X[(ai * HALF + wr * 64 + m * 16 + fr) * 4 + wc] = (f32x2){mx, sm};
            }
        asm volatile("s_waitcnt lgkmcnt(0)" ::: "memory"); __builtin_amdgcn_s_barrier(); asm volatile("" ::: "memory");
        const int row0 = u.pm * BM + wr * 64 + fr;
#pragma unroll
        for (int ai = 0; ai < 2; ++ai)
#pragma unroll
            for (int m = 0; m < 4; ++m) {
                const int rl = ai * HALF + wr * 64 + m * 16 + fr;
                const f32x2 x0 = X[rl * 4 + 0], x1 = X[rl * 4 + 1], x2 = X[rl * 4 + 2], x3 = X[rl * 4 + 3];
                const float Mx = fmaxf(fmaxf(x0.x, x1.x), fmaxf(x2.x, x3.x));
                const float tot = x0.y * fast_exp(x0.x - Mx) + x1.y * fast_exp(x1.x - Mx) + x2.y * fast_exp(x2.x - Mx) + x3.y * fast_exp(x3.x - Mx);
                const float scl = fast_exp(mw[ai][m] - Mx) * fast_rcp(tot);
                bf16_t* rowp = P + ((size_t)u.pb * S + row0 + ai * HALF + m * 16) * 256 + wc * 32 + fq * 8;
#pragma unroll
                for (int bj = 0; bj < 2; ++bj) *(u32x4*)(rowp + bj * HALF) = pack8(acc[ai][bj][m][0] * scl, acc[ai][bj][m][1] * scl);
            }
        asm volatile("s_waitcnt lgkmcnt(0)" ::: "memory");
    }
};
struct Params { const float* in[39]; float* out; unsigned char* ws; int ph_lo, ph_hi; };
typedef const Params __attribute__((address_space(4)))* KP;
__device__ __forceinline__ KP kargs() { KP q = (KP)__builtin_amdgcn_kernarg_segment_ptr(); asm volatile("" : "+s"(q)); return q; }

__device__ __forceinline__ void p0_transpose_tile(const float* __restrict__ W, int K, int N, const float* sA, const float* sB, int split, bf16_t* __restrict__ Wt, int tile, LAS float* scr, int tid) {
    const int tiles_n = N >> 6, tk = tile / tiles_n, tn = tile % tiles_n, k0 = tk * 64, n0 = tn * 64;
#pragma unroll
    for (int j = 0; j < 8; ++j) { const int i = tid + 512 * j, k = i >> 6, n = i & 63; float s = 1.f; if (sA) { const int kk = k0 + k; s = (kk < split) ? sA[kk] : sB[kk - split]; }
        scr[k * 65 + n] = W[(size_t)(k0 + k) * N + n0 + n] * s; }
    __syncthreads();
    { const int n = tid >> 3, ks = (tid & 7) * 8; f32x4 a, b;
#pragma unroll
      for (int j = 0; j < 4; ++j) { a[j] = scr[(ks + j) * 65 + n]; b[j] = scr[(ks + 4 + j) * 65 + n]; }
      *(u32x4*)(Wt + (size_t)(n0 + n) * K + k0 + ks) = pack8(a, b); }
    __syncthreads();
}
__device__ __forceinline__ void p0_colsum(const float* __restrict__ W, int N, const float* g, const float* b, float* c1, float* c2, int item, LAS float* scr, int tid) {
    const int n = item * 64 + (tid & 63), ks = tid >> 6; float s1 = 0.f, s2 = 0.f;
    for (int k = ks * 128; k < ks * 128 + 128; ++k) { const float w = W[(size_t)k * N + n]; s1 += bf2f(f2bf(g[k] * w)); s2 += b[k] * w; }
    scr[(ks * 64 + (tid & 63)) * 2] = s1; scr[(ks * 64 + (tid & 63)) * 2 + 1] = s2;
    __syncthreads();
    if (tid < 64) { float a = 0.f, q = 0.f;
#pragma unroll
        for (int j = 0; j < 8; ++j) { a += scr[(j * 64 + tid) * 2]; q += scr[(j * 64 + tid) * 2 + 1]; }
        c1[n] = a; c2[n] = q; }
    __syncthreads();
}
__device__ __forceinline__ void ln_row_bf16(const float* __restrict__ x, const float* g, const float* b, bf16_t* __restrict__ o, float* st, int lane) {
    f32x4 v[4]; float s = 0.f;
#pragma unroll
    for (int j = 0; j < 4; ++j) { v[j] = *(const f32x4*)(x + j * 256 + lane * 4); s += (v[j][0] + v[j][1]) + (v[j][2] + v[j][3]); }
    const float mu = wave_sum(s) * (1.0f / 1024.0f); float q = 0.f;
#pragma unroll
    for (int j = 0; j < 4; ++j) { v[j] = v[j] - mu; q += (v[j][0] * v[j][0] + v[j][1] * v[j][1]) + (v[j][2] * v[j][2] + v[j][3] * v[j][3]); }
    const float rstd = rsqrtf(wave_sum(q) * (1.0f / 1024.0f) + 1e-5f);
#pragma unroll
    for (int j = 0; j < 4; ++j) { const f32x4 gg = *(const f32x4*)(g + j * 256 + lane * 4), bb = *(const f32x4*)(b + j * 256 + lane * 4); const f32x4 y = v[j] * rstd * gg + bb;
        u32x2 w; w.x = cvt_pk_bf16(y[0], y[1]); w.y = cvt_pk_bf16(y[2], y[3]); *(u32x2*)(o + j * 256 + lane * 4) = w; }
    if (st && lane == 0) { st[0] = mu; st[1] = rstd; }
}
__device__ __forceinline__ void p0_s5_tables(KP p, int g, LAS unsigned char* lds, int tid) {
    LAS float* lam = (LAS float*)lds;
    LAS float* Bb = lam + 33 * 128;
    LAS float* Cc = Bb + 2048;
    LAS float* Kt = Cc + 2048;
    const float* a_re = p->in[5] + g * 64; const float* a_im = p->in[6] + g * 64; const float dt = expf(p->in[7][g]);
    for (int i = tid; i < 33 * 64; i += NTHREADS) { const int tau = i >> 6, pp = i & 63; const float mag = expf((float)tau * dt * a_re[pp]); float sn, cs; sincosf((float)tau * dt * a_im[pp], &sn, &cs);
        lam[i * 2] = mag * cs; lam[i * 2 + 1] = mag * sn; }
    for (int i = tid; i < 1024; i += NTHREADS) { const int pp = i >> 4, h = i & 15;
        const float ar = a_re[pp], ai = a_im[pp]; const float mag = expf(dt * ar); float sn, cs; sincosf(dt * ai, &sn, &cs); const float lr = mag * cs, li = mag * sn;
        const float den = ar * ar + ai * ai; const float qr = ((lr - 1.f) * ar + li * ai) / den, qi = (li * ar - (lr - 1.f) * ai) / den;
        const float br = p->in[8][(g * 64 + pp) * 16 + h], bi = p->in[9][(g * 64 + pp) * 16 + h];
        Bb[i * 2] = qr * br - qi * bi; Bb[i * 2 + 1] = qr * bi + qi * br;
        const int ho = i >> 6, p2 = i & 63; Cc[i * 2] = p->in[10][(g * 16 + ho) * 64 + p2]; Cc[i * 2 + 1] = p->in[11][(g * 16 + ho) * 64 + p2]; }
    __syncthreads();
    { const int e = tid >> 1, ho = e >> 4, hi = e & 15, half = tid & 1;
      for (int tau = 0; tau < 32; ++tau) { float s = 0.f;
          for (int pp = half * 32; pp < half * 32 + 32; ++pp) { const float cr = Cc[(ho * 64 + pp) * 2], ci = Cc[(ho * 64 + pp) * 2 + 1], lr = lam[(tau * 64 + pp) * 2], li = lam[(tau * 64 + pp) * 2 + 1];
              const float xr = cr * lr - ci * li, xi = cr * li + ci * lr; s += xr * Bb[(pp * 16 + hi) * 2] - xi * Bb[(pp * 16 + hi) * 2 + 1]; }
          s += __shfl_xor(s, 1); if (half == 0) Kt[tau * 256 + e] = s; } }
    __syncthreads();
    bf16_t* T = (bf16_t*)(p->ws + WS_S5T) + (size_t)g * 512 * 640;
    for (int q = tid; q < 512 * 80; q += NTHREADS) { const int n = q / 80, kc = q % 80, i = n >> 4, ho = n & 15; f32x4 a, b;
        if (kc < 64) { const int j = kc >> 1, hi0 = (kc & 1) * 8;
            if (i >= j) { LAS float* src = Kt + (i - j) * 256 + ho * 16 + hi0;
#pragma unroll
                for (int x = 0; x < 4; ++x) { a[x] = src[x]; b[x] = src[4 + x]; } }
            else { a = (f32x4){0.f, 0.f, 0.f, 0.f}; b = a; } }
        else { const int p0 = (kc - 64) * 4;
#pragma unroll
            for (int x = 0; x < 4; ++x) { const int pp = p0 + x; const float cr = Cc[(ho * 64 + pp) * 2], ci = Cc[(ho * 64 + pp) * 2 + 1], lr = lam[((i + 1) * 64 + pp) * 2], li = lam[((i + 1) * 64 + pp) * 2 + 1];
                const float re = cr * lr - ci * li, im = cr * li + ci * lr; if (x < 2) { a[2 * x] = re; a[2 * x + 1] = -im; } else { b[2 * (x - 2)] = re; b[2 * (x - 2) + 1] = -im; } } }
        *(u32x4*)(T + (size_t)n * 640 + kc * 8) = pack8(a, b); }
    bf16_t* Pm = (bf16_t*)(p->ws + WS_S5P) + (size_t)g * 256 * 512;
    for (int q = tid; q < 256 * 64; q += NTHREADS) { const int n = q >> 6, kc = q & 63; f32x4 a = (f32x4){0.f, 0.f, 0.f, 0.f}, b = a;
        if (n < 128) { const int pp = n >> 1, im = n & 1, j = kc >> 1, hi0 = (kc & 1) * 8; const float lr = lam[((CH - 1 - j) * 64 + pp) * 2], li = lam[((CH - 1 - j) * 64 + pp) * 2 + 1];
#pragma unroll
            for (int x = 0; x < 8; ++x) { const float br = Bb[(pp * 16 + hi0 + x) * 2], bi = Bb[(pp * 16 + hi0 + x) * 2 + 1]; const float v = im ? (lr * bi + li * br) : (lr * br - li * bi); if (x < 4) a[x] = v; else b[x - 4] = v; } }
        *(u32x4*)(Pm + (size_t)n * 512 + kc * 8) = pack8(a, b); }
    if (tid < 128) ((float*)(p->ws + WS_LAML))[g * 128 + tid] = lam[CH * 128 + tid];
    __syncthreads();
}
__device__ __forceinline__ void p0_prep(KP p, LAS unsigned char* lds, int G, int c) {
    const int tid = threadIdx.x, lane = tid & 63, wave = tid >> 6;
    LAS float* scr = (LAS float*)lds;
    unsigned char* ws = p->ws;
    constexpr int I_S5 = 32, T_IN = 16 * 24, T_GLU = 64, T_SQ = 256, T_F1 = 16 * 64, T_F2 = 64 * 16;
    constexpr int I_TR = T_IN + T_GLU + 5 * T_SQ + T_F1 + T_F2, I_CS = 16 + 64, I_GT = 128, I_GB = 2, I_SP = 1, I_Z = 112 + 6, I_LNX = M / 8, I_LNM = 4096 / 8;
    constexpr int NITEMS = I_S5 + I_TR + I_CS + I_GT + I_GB + I_SP + I_Z + I_LNX + I_LNM;
    for (int it = c; it < NITEMS; it += G) {
        int r = it;
        if (r < I_S5) { p0_s5_tables(p, r, lds, tid); continue; } r -= I_S5;
        if (r < I_TR) {
            if (r < T_IN) { p0_transpose_tile(p->in[4], 1024, 1536, nullptr, nullptr, 0, (bf16_t*)(ws + WS_WIN), r, scr, tid); continue; } r -= T_IN;
            if (r < T_GLU) { p0_transpose_tile(p->in[13], 512, 512, nullptr, nullptr, 0, (bf16_t*)(ws + WS_WGLU), r, scr, tid); continue; } r -= T_GLU;
            if (r < T_SQ) { p0_transpose_tile(p->in[24], 1024, 1024, p->in[22], p->in[23], 512, (bf16_t*)(ws + WS_WMIX), r, scr, tid); continue; } r -= T_SQ;
            if (r < T_SQ) { p0_transpose_tile(p->in[29], 1024, 1024, p->in[25], p->in[25], 1 << 30, (bf16_t*)(ws + WS_WQ), r, scr, tid); continue; } r -= T_SQ;
            if (r < T_SQ) { p0_transpose_tile(p->in[30], 1024, 1024, nullptr, nullptr, 0, (bf16_t*)(ws + WS_WK), r, scr, tid); continue; } r -= T_SQ;
            if (r < T_SQ) { p0_transpose_tile(p->in[31], 1024, 1024, nullptr, nullptr, 0, (bf16_t*)(ws + WS_WV), r, scr, tid); continue; } r -= T_SQ;
            if (r < T_SQ) { p0_transpose_tile(p->in[32], 1024, 1024, nullptr, nullptr, 0, (bf16_t*)(ws + WS_WO), r, scr, tid); continue; } r -= T_SQ;
            if (r < T_F1) { p0_transpose_tile(p->in[35], 1024, 4096, p->in[33], p->in[33], 1 << 30, (bf16_t*)(ws + WS_WF1), r, scr, tid); continue; } r -= T_F1;
            p0_transpose_tile(p->in[36], 4096, 1024, nullptr, nullptr, 0, (bf16_t*)(ws + WS_WF2), r, scr, tid); continue;
        } r -= I_TR;
        if (r < I_CS) {
            if (r < 16) p0_colsum(p->in[29], 1024, p->in[25], p->in[26], (float*)(ws + WS_C1Q), (float*)(ws + WS_C2Q), r, scr, tid);
            else p0_colsum(p->in[35], 4096, p->in[33], p->in[34], (float*)(ws + WS_C1F), (float*)(ws + WS_C2F), r - 16, scr, tid);
            continue;
        } r -= I_CS;
        if (r < I_GT) {
            const int q = r * 512 + tid, hp = q >> 14, n = (q >> 6) & 255, k0 = (q & 63) * 8;
            const int tap = k0 >> 7, cc0 = k0 & 127, co = hp * 128 + (n & 127), ho = co >> 6; const float* Wg = (n >> 7) ? p->in[19] : p->in[17];
            f32x4 a = (f32x4){0.f, 0.f, 0.f, 0.f}, b = a;
            if (((hp * 128 + cc0) >> 6) == ho) {
#pragma unroll
                for (int x = 0; x < 8; ++x) { const int ci = hp * 128 + cc0 + x; const float v = p->in[15][tap * 512 + ci] * Wg[(ho * 64 + (ci & 63)) * 64 + (co & 63)]; if (x < 4) a[x] = v; else b[x - 4] = v; } }
            *(u32x4*)((bf16_t*)(ws + WS_GATES) + ((size_t)(hp * 256 + n) * 512 + k0)) = pack8(a, b);
            continue;
        } r -= I_GT;
        if (r < I_GB) { const int q = r * 512 + tid, hp = q >> 8, n = q & 255, co = hp * 128 + (n & 127), ho = co >> 6; const float* Wg = (n >> 7) ? p->in[19] : p->in[17];
            float s = ((n >> 7) ? p->in[20] : p->in[18])[co];
            for (int i = 0; i < 64; ++i) s += p->in[16][ho * 64 + i] * Wg[(ho * 64 + i) * 64 + (co & 63)];
            ((float*)(ws + WS_GBIAS))[q] = s; continue; } r -= I_GB;
        if (r < I_SP) { ((float*)(ws + WS_SP8))[tid] = 8.0f * log1pf(expf(-p->in[21][tid])); continue; } r -= I_SP;
        if (r < I_Z) {
            if (r < 112) *(u32x4*)(ws + WS_ZERO_BEG + ((size_t)r * 512 + tid) * 16) = (u32x4){0u, 0u, 0u, 0u};
            else { const int q = (r - 112) * 512 + tid;
                const int b = q / 192, w = q % 192; *(u32x4*)(ws + WS_XL + ((size_t)b * XLROWS * 512) * 2 + (size_t)w * 16) = (u32x4){0u, 0u, 0u, 0u}; }
            continue;
        } r -= I_Z;
        if (r < I_LNX) { const int row = r * 8 + wave; ln_row_bf16(p->in[0] + (size_t)row * 1024, p->in[2], p->in[3], (bf16_t*)(ws + WS_H0B) + (size_t)row * 1024, (float*)(ws + WS_STATS0) + 2 * row, lane); continue; } r -= I_LNX;
        { const int row = r * 8 + wave; ln_row_bf16(p->in[1] + (size_t)row * 1024, p->in[27], p->in[28], (bf16_t*)(ws + WS_MEMN) + (size_t)row * 1024, nullptr, lane); }
    }
}
__device__ __forceinline__ void p3_s5_scan(KP p, int c) {
    const int gt = c * NTHREADS + threadIdx.x; if (gt >= NG * B * 64) return;
    const int g = gt >> 10, b = (gt >> 6) & 15, pp = gt & 63;
    const float lr = ((const float*)(p->ws + WS_LAML))[g * 128 + pp * 2], li = ((const float*)(p->ws + WS_LAML))[g * 128 + pp * 2 + 1];
    const float* xe = (const float*)(p->ws + WS_XEND) + ((size_t)(g * 1024 + b * NCH)) * 128 + 2 * pp;
    bf16_t* uo = (bf16_t*)(p->ws + WS_U) + ((size_t)(g * 1024 + b * NCH)) * 640 + 512 + 2 * pp;
    float xr = 0.f, xi = 0.f;
    for (int c0 = 0; c0 < NCH; c0 += 8) {
        f32x2 e[8];
#pragma unroll
        for (int j = 0; j < 8; ++j) e[j] = *(const f32x2*)(xe + (size_t)(c0 + j) * 128);
#pragma unroll
        for (int j = 0; j < 8; ++j) { *(unsigned*)(uo + (size_t)(c0 + j) * 640) = cvt_pk_bf16(xr, xi);
            const float nr = lr * xr - li * xi + e[j].x, ni = lr * xi + li * xr + e[j].y; xr = nr; xi = ni; }
    }
}
__device__ __forceinline__ void p3_lru_pass1(KP p, int G, int c) {
    const int ch = threadIdx.x; const float* LA = (const float*)(p->ws + WS_LA); const float* LB = (const float*)(p->ws + WS_LB); float* agg = (float*)(p->ws + WS_AGG);
    for (int it = c; it < B * NCH; it += G) {
        const size_t base = (size_t)it * CH * 512 + ch; float A = 1.f, h = 0.f;
#pragma unroll 8
        for (int t = 0; t < CH; ++t) { const float a = LA[base + (size_t)t * 512], bb = LB[base + (size_t)t * 512]; h = a * h + bb; A *= a; }
        agg[((size_t)it * 2) * 512 + ch] = A; agg[((size_t)it * 2 + 1) * 512 + ch] = h;
    }
}
__device__ __forceinline__ void p4_lru_pass2(KP p, LAS unsigned char* lds, int G, int c) {
    const int ch = threadIdx.x, lane = ch & 63, wave = ch >> 6; LAS float* yb = (LAS float*)lds;
    const float* LA = (const float*)(p->ws + WS_LA); const float* LB = (const float*)(p->ws + WS_LB); const float* agg = (const float*)(p->ws + WS_AGG);
    const bf16_t* GG = (const bf16_t*)(p->ws + WS_GG); bf16_t* YC = (bf16_t*)(p->ws + WS_YCAT);
    for (int it = c; it < B * NCH; it += G) {
        const int b = it >> 6, chunk = it & 63; float h = 0.f;
        for (int cc = 0; cc < chunk; ++cc) { const size_t a0 = ((size_t)(b * NCH + cc) * 2) * 512 + ch; h = agg[a0] * h + agg[a0 + 512]; }
        const size_t base = (size_t)it * CH * 512 + ch;
#pragma unroll 8
        for (int t = 0; t < CH; ++t) { const float a = LA[base + (size_t)t * 512], bb = LB[base + (size_t)t * 512]; h = a * h + bb; yb[t * 512 + ch] = h * bf2f(GG[base + (size_t)t * 512]); }
        __syncthreads();
#pragma unroll
        for (int q = 0; q < 4; ++q) { const int t = wave + 8 * q; const f32x4 v0 = *(LAS f32x4*)(yb + t * 512 + lane * 8), v1 = *(LAS f32x4*)(yb + t * 512 + lane * 8 + 4);
            float s = (v0[0] * v0[0] + v0[1] * v0[1]) + (v0[2] * v0[2] + v0[3] * v0[3]) + (v1[0] * v1[0] + v1[1] * v1[1]) + (v1[2] * v1[2] + v1[3] * v1[3]);
            const float rs = rsqrtf(wave_sum(s) * (1.0f / 512.0f) + 1e-6f);
            *(u32x4*)(YC + ((size_t)it * CH + t) * 1024 + 512 + lane * 8) = pack8(v0 * rs, v1 * rs); }
        __syncthreads();
    }
}
__device__ __forceinline__ void p13_final_ln(KP p, int G, int c) {
    const int lane = threadIdx.x & 63, wave = threadIdx.x >> 6; const float* st3 = (const float*)(p->ws + WS_STATS3);
    for (int row = c * 8 + wave; row < M; row += G * 8) {
        const f32x2 st = *(const f32x2*)(st3 + 2 * (size_t)row); const float mu = st.x * (1.0f / 1024.0f), rstd = rsqrtf(st.y * (1.0f / 1024.0f) - mu * mu + 1e-5f);
        float* o = p->out + (size_t)row * 1024;
#pragma unroll
        for (int j = 0; j < 4; ++j) { const f32x4 v = *(const f32x4*)(o + j * 256 + lane * 4), gg = *(const f32x4*)(p->in[37] + j * 256 + lane * 4), bb = *(const f32x4*)(p->in[38] + j * 256 + lane * 4);
            *(f32x4*)(o + j * 256 + lane * 4) = (v - mu) * rstd * gg + bb; }
    }
}

constexpr int NPHASES = 14;
#ifndef PH_MASK
#define PH_MASK 0x3fff
#endif
__global__ void __launch_bounds__(NTHREADS, 2) mega(Params p_unused) {
    extern __shared__ __attribute__((aligned(16))) unsigned char lds_raw[];
    LAS unsigned char* lds = (LAS unsigned char*)lds_raw;
    const int G = gridDim.x, c = blockIdx.x;
    unsigned char* ws; int lo, hi; { KP p = kargs(); ws = p->ws; lo = p->ph_lo; hi = p->ph_hi; }
#ifndef MK_CGSYNCS
#define MK_CGSYNCS 1
#endif
    volatile LAS unsigned* bst = (volatile LAS unsigned*)(lds + LDS_BARW);
    if (threadIdx.x < 4) bst[threadIdx.x] = 0u;
    __syncthreads();
    XcdBarrier xbar; xbar.bar = (unsigned*)ws; xbar.x = 0; xbar.st = bst;
    if (hi - lo > 1) xbar = xcd_barrier_post((unsigned*)ws, bst);
#define PH_END(k) if ((k) + 1 < hi) { if ((k) - lo < MK_CGSYNCS) cg::this_grid().sync(); else xcd_barrier(xbar); } else __syncthreads();
#if (PH_MASK >> 0) & 1
        if (lo <= 0 && 0 < hi) { KP p = kargs(); p0_prep(p, lds, G, c); PH_END(0) }
#endif
#if (PH_MASK >> 1) & 1
        if (lo <= 1 && 1 < hi) { KP p = kargs(); {
            { PlainGeom<1024, 1024, M, DIN, 1024> g; g.A = (const bf16_t*)(ws + WS_H0B); g.Bt = (const bf16_t*)(ws + WS_WIN);
              EpiZ E; E.U = (bf16_t*)(ws + WS_U); E.XL = (bf16_t*)(ws + WS_XL); E.GG = (bf16_t*)(ws + WS_GG); gemm_phase(lds, g, E, G, c); }
            { PlainGeom<1024, 1024, 4096, 1024, 1024> g; g.A = (const bf16_t*)(ws + WS_MEMN); g.Bt = (const bf16_t*)(ws + WS_WK);
              EpiBf16 E; E.O = (bf16_t*)(ws + WS_KMAT); E.ldc = 1024; E.bdiv = 1; E.ob0 = 0; E.ob1 = 0; gemm_phase(lds, g, E, G, c); }
            { PlainGeom<1024, 1024, 1024, 4096, 1024> g; g.A = (const bf16_t*)(ws + WS_WV); g.Bt = (const bf16_t*)(ws + WS_MEMN);
              EpiBf16 E; E.O = (bf16_t*)(ws + WS_VT); E.ldc = 4096; E.bdiv = 1; E.ob0 = 0; E.ob1 = 0; gemm_phase(lds, g, E, G, (c + G - 64) % G); }
        } PH_END(1) }
#endif
#if (PH_MASK >> 2) & 1
        if (lo <= 2 && 2 < hi) { KP p = kargs(); {
            { GeomT<640, 512, 8, 4, 1, NG, 256L * 640, 1024L * 640, 0, 1, 0, 256L * 512, 0, 0> g; g.A = (const bf16_t*)(ws + WS_U); g.Bt = (const bf16_t*)(ws + WS_S5P);
              EpiXend E; E.X = (float*)(ws + WS_XEND); gemm_phase(lds, g, E, G, c); }
            { GeomT<512, 512, 8, 8, 1, 64, 256L * 512, 128, (long)XLROWS * 512, 16, 0, 256L * 512, 0, 1> g; g.A = (const bf16_t*)(ws + WS_XL); g.Bt = (const bf16_t*)(ws + WS_GATES);
              EpiGates E; E.XL = (const bf16_t*)(ws + WS_XL); E.cw = p->in[15]; E.cb = p->in[16]; E.gbias = (const float*)(ws + WS_GBIAS); E.sp8 = (const float*)(ws + WS_SP8);
              E.LA = (float*)(ws + WS_LA); E.LB = (float*)(ws + WS_LB); gemm_phase(lds, g, E, G, (c + G - 128) % G); }
        } PH_END(2) }
#endif
#if (PH_MASK >> 3) & 1
        if (lo <= 3 && 3 < hi) { KP p = kargs(); p3_s5_scan(p, c); p3_lru_pass1(p, G, G - 1 - c); PH_END(3) }
#endif
#if (PH_MASK >> 4) & 1
        if (lo <= 4 && 4 < hi) { KP p = kargs(); {
            { GeomT<640, 640, 10, 4, 2, NG, 256L * 640, 1024L * 640, 0, 1, 256L * 640, 512L * 640, 0, 0> g; g.A = (const bf16_t*)(ws + WS_U); g.Bt = (const bf16_t*)(ws + WS_S5T);
              EpiS5 E; E.U = (const bf16_t*)(ws + WS_U); E.dd = p->in[12]; E.Y1 = (bf16_t*)(ws + WS_Y1); gemm_phase(lds, g, E, G, c); }
            p4_lru_pass2(p, lds, G, c);
        } PH_END(4) }
#endif
#if (PH_MASK >> 5) & 1
        if (lo <= 5 && 5 < hi) { KP p = kargs(); { PlainGeom<512, 512, M, 512, 512> g; g.A = (const bf16_t*)(ws + WS_Y1); g.Bt = (const bf16_t*)(ws + WS_WGLU);
            EpiGlu E; E.Y1 = (const bf16_t*)(ws + WS_Y1); E.bg = p->in[14]; E.YC = (bf16_t*)(ws + WS_YCAT); E.ssq = (float*)(ws + WS_SSQ); gemm_phase(lds, g, E, G, c); } PH_END(5) }
#endif
#if (PH_MASK >> 6) & 1
        if (lo <= 6 && 6 < hi) { KP p = kargs(); { PlainGeom<1024, 1024, M, 1024, 1024> g; g.A = (const bf16_t*)(ws + WS_YCAT); g.Bt = (const bf16_t*)(ws + WS_WMIX);
            EpiRes<0, true, 8> E; E.prev = p->in[0]; E.pstats = (const float*)(ws + WS_STATS0); E.pg = p->in[2]; E.pb_ = p->in[3]; E.vout = (float*)(ws + WS_V1); E.vb = (bf16_t*)(ws + WS_V1B);
            E.ostats = (float*)(ws + WS_STATS1); E.ssq = (const float*)(ws + WS_SSQ); gemm_phase(lds, g, E, G, c); } PH_END(6) }
#endif
#if (PH_MASK >> 7) & 1
        if (lo <= 7 && 7 < hi) { KP p = kargs(); { PlainGeom<1024, 1024, M, 1024, 1024> g; g.A = (const bf16_t*)(ws + WS_V1B); g.Bt = (const bf16_t*)(ws + WS_WQ);
            EpiFold<0> E; E.pstats = (const float*)(ws + WS_STATS1); E.c1 = (const float*)(ws + WS_C1Q); E.c2 = (const float*)(ws + WS_C2Q); E.O = (bf16_t*)(ws + WS_Q); E.ldc = 1024; E.sc = 0.0625f;
            gemm_phase(lds, g, E, G, c); } PH_END(7) }
#endif
#if (PH_MASK >> 8) & 1
        if (lo <= 8 && 8 < hi) { KP p = kargs(); { GeomT<1024, 1024, 4, 8, 1, 64, 256L * 1024, 2048L * 1024, 256, 4, 0, 256L * 1024, 256, 0> g; g.A = (const bf16_t*)(ws + WS_Q); g.Bt = (const bf16_t*)(ws + WS_KMAT);
            EpiSoftmax E; E.P = (bf16_t*)(ws + WS_PROB); gemm_phase(lds, g, E, G, c); } PH_END(8) }
#endif
#if (PH_MASK >> 9) & 1
        if (lo <= 9 && 9 < hi) { KP p = kargs(); { GeomT<256, 4096, 4, 8, 1, 64, 256L * 256, 4L * 2048 * 256, 2048L * 256, 4, 0, 256, 256L * 4096, 0> g; g.A = (const bf16_t*)(ws + WS_PROB); g.Bt = (const bf16_t*)(ws + WS_VT);
            EpiBf16 E; E.O = (bf16_t*)(ws + WS_AO); E.ldc = 1024; E.bdiv = 4; E.ob0 = 2048L * 1024; E.ob1 = 256; gemm_phase(lds, g, E, G, c); } PH_END(9) }
#endif
#if (PH_MASK >> 10) & 1
        if (lo <= 10 && 10 < hi) { KP p = kargs(); { PlainGeom<1024, 1024, M, 1024, 1024> g; g.A = (const bf16_t*)(ws + WS_AO); g.Bt = (const bf16_t*)(ws + WS_WO);
            EpiRes<1, true, -1> E; E.prev = (const float*)(ws + WS_V1); E.pstats = (const float*)(ws + WS_STATS1); E.pg = p->in[25]; E.pb_ = p->in[26]; E.vout = (float*)(ws + WS_V2); E.vb = (bf16_t*)(ws + WS_V1B);
            E.ostats = (float*)(ws + WS_STATS2); E.ssq = nullptr; gemm_phase(lds, g, E, G, c); } PH_END(10) }
#endif
#if (PH_MASK >> 11) & 1
        if (lo <= 11 && 11 < hi) { KP p = kargs(); { PlainGeom<1024, 1024, M, DFF, 1024> g; g.A = (const bf16_t*)(ws + WS_V1B); g.Bt = (const bf16_t*)(ws + WS_WF1);
            EpiFold<1> E; E.pstats = (const float*)(ws + WS_STATS2); E.c1 = (const float*)(ws + WS_C1F); E.c2 = (const float*)(ws + WS_C2F); E.O = (bf16_t*)(ws + WS_HDN); E.ldc = DFF; E.sc = 1.f;
            gemm_phase(lds, g, E, G, c); } PH_END(11) }
#endif
#if (PH_MASK >> 12) & 1
        if (lo <= 12 && 12 < hi) { KP p = kargs(); { PlainGeom<DFF, DFF, M, 1024, DFF> g; g.A = (const bf16_t*)(ws + WS_HDN); g.Bt = (const bf16_t*)(ws + WS_WF2);
            EpiRes<1, false, -1> E; E.prev = (const float*)(ws + WS_V2); E.pstats = (const float*)(ws + WS_STATS2); E.pg = p->in[33]; E.pb_ = p->in[34]; E.vout = p->out; E.vb = nullptr;
            E.ostats = (float*)(ws + WS_STATS3); E.ssq = nullptr; gemm_phase(lds, g, E, G, c); } PH_END(12) }
#endif
#if (PH_MASK >> 13) & 1
        if (lo <= 13 && 13 < hi) { KP p = kargs(); p13_final_ln(p, G, c); PH_END(13) }
#endif
#undef PH_END
}
}
#ifndef MK_MULTI
#define MK_MULTI 0
#endif
#ifndef MK_DEBUG
#define MK_DEBUG 0
#endif
#if MK_DEBUG
namespace dbg {
using namespace fp;
__device__ __forceinline__ float gelu_ref(float x) { const float k = 0.7978845608028654f; float u = k * (x + 0.044715f * x * x * x); return 0.5f * x * (1.0f + tanhf(u)); }
struct CmpArgs { const unsigned char* ws; const float* ref; const float* aux0; const float* aux1; int mode, rows, cols, ldr, bd; float* acc; };
__global__ void __launch_bounds__(256) k_cmp(CmpArgs a) {
    __shared__ float red[8];
    float d2 = 0.f, r2 = 0.f; const size_t n = (size_t)a.rows * a.cols;
    for (size_t i = (size_t)blockIdx.x * 256 + threadIdx.x; i < n; i += (size_t)gridDim.x * 256) {
        const int t = (int)(i / a.cols), c = (int)(i % a.cols); const size_t row = (size_t)a.bd * S + t;
        float f = 0.f, r = a.ref[(size_t)t * a.ldr + c];
        switch (a.mode) {
        case 1: { const int g = c >> 4, hi = c & 15; f = bf2f(((const bf16_t*)(a.ws + WS_U))[((size_t)(g * 1024 + a.bd * NCH + (t >> 5))) * 640 + (t & 31) * 16 + hi]); } break;
        case 2: f = bf2f(((const bf16_t*)(a.ws + WS_XL))[((size_t)(a.bd * XLROWS + 3 + t)) * 512 + c]); break;
        case 3: f = bf2f(((const bf16_t*)(a.ws + WS_GG))[row * 512 + c]); r = gelu_ref(r); break;
        case 4: f = bf2f(((const bf16_t*)(a.ws + WS_KMAT))[((size_t)(a.bd * 256 + t)) * 1024 + c]); break;
        case 5: f = bf2f(((const bf16_t*)(a.ws + WS_VT))[(size_t)c * 4096 + a.bd * 256 + t]); break;
        case 6: f = 1.0f - ((const float*)(a.ws + WS_LA))[row * 512 + c]; r = 1.0f - r; break;
        case 7: f = ((const float*)(a.ws + WS_LB))[row * 512 + c]; break;
        case 8: f = bf2f(((const bf16_t*)(a.ws + WS_Y1))[row * 512 + c]); break;
        case 9: f = bf2f(((const bf16_t*)(a.ws + WS_YCAT))[row * 1024 + 512 + c]) * a.aux0[c]; break;
        case 10: f = bf2f(((const bf16_t*)(a.ws + WS_YCAT))[row * 1024 + c]) * rsqrtf(((const float*)(a.ws + WS_SSQ))[row] * (1.0f / 512.0f) + 1e-6f) * a.aux0[c]; break;
        case 11: { const float* st = (const float*)(a.ws + WS_STATS1) + 2 * row; const float mu = st[0] * (1.0f / 1024.0f), rs = rsqrtf(st[1] * (1.0f / 1024.0f) - mu * mu + 1e-5f);
            f = (((const float*)(a.ws + WS_V1))[row * 1024 + c] - mu) * rs * a.aux0[c] + a.aux1[c]; } break;
        case 12: f = 16.0f * bf2f(((const bf16_t*)(a.ws + WS_Q))[row * 1024 + c]); break;
        case 13: f = bf2f(((const bf16_t*)(a.ws + WS_AO))[row * 1024 + c]); break;
        case 14: { const float* st = (const float*)(a.ws + WS_STATS2) + 2 * row; const float mu = st[0] * (1.0f / 1024.0f), rs = rsqrtf(st[1] * (1.0f / 1024.0f) - mu * mu + 1e-5f);
            f = (((const float*)(a.ws + WS_V2))[row * 1024 + c] - mu) * rs * a.aux0[c] + a.aux1[c]; } break;
        case 15: f = bf2f(((const bf16_t*)(a.ws + WS_HDN))[row * 4096 + c]); break;
        default: break;
        }
        const float d = f - r; d2 += d * d; r2 += r * r;
    }
    for (int o = 32; o > 0; o >>= 1) { d2 += __shfl_xor(d2, o); r2 += __shfl_xor(r2, o); }
    if ((threadIdx.x & 63) == 0) { red[(threadIdx.x >> 6) * 2] = d2; red[(threadIdx.x >> 6) * 2 + 1] = r2; }
    __syncthreads();
    if (threadIdx.x == 0) { atomicAdd(a.acc + a.mode * 2, red[0] + red[2] + red[4] + red[6]); atomicAdd(a.acc + a.mode * 2 + 1, red[1] + red[3] + red[5] + red[7]); }
}
__global__ void k_final(const float* acc, float* out, float tol) {
    if (threadIdx.x != 0 || blockIdx.x != 0) return;
    for (int m = 1; m <= 15; ++m) { const float d = acc[m * 2], r = acc[m * 2 + 1]; const float e = sqrtf(d / fmaxf(r, 1e-30f));
        if (!(e <= tol)) { float k = 1e4f; if (!(e < 0.1f)) k = 1e5f; if (!(e < 1.0f)) k = 1e6f; out[0] = (10.0f + m) * k; return; } }
}
}
#endif

extern "C" void kernel_launch(void* const* d_in, const int* in_sizes, int n_in, void* d_out, int out_size, void* d_ws, size_t ws_size, hipStream_t stream) {
    (void)in_sizes; (void)n_in; (void)out_size;
    static int grid = 0;
    if (grid == 0) {
        int dev = 0, cus = 0, per_cu = 0;
        hipGetDevice(&dev); hipDeviceGetAttribute(&cus, hipDeviceAttributeMultiprocessorCount, dev);
        hipFuncSetAttribute((const void*)fp::mega, hipFuncAttributeMaxDynamicSharedMemorySize, fp::LDS_BYTES);
        hipOccupancyMaxActiveBlocksPerMultiprocessor(&per_cu, (const void*)fp::mega, fp::NTHREADS, fp::LDS_BYTES);
        if (per_cu < 1) { fprintf(stderr, "kernel_launch: occupancy query says %d blocks/CU\n", per_cu); per_cu = 1; }
        grid = cus * 1;
        if (ws_size < fp::WS_END) fprintf(stderr, "kernel_launch: workspace too small: %zu < %zu\n", ws_size, (size_t)fp::WS_END);
        (void)hipGetLastError();
    }
    fp::Params p{};
    for (int i = 0; i < 39; ++i) p.in[i] = (const float*)d_in[i];
    p.out = (float*)d_out; p.ws = (unsigned char*)d_ws;
#if MK_DEBUG
    const int bd = 5;
    float* nws = (float*)d_out;
    float* f1x = nws + nv::naive_floats(1);
    float* acc = (float*)((unsigned char*)d_ws + fp::WS_DBG);
    hipMemsetAsync(acc, 0, 256, stream);
    nv::NaiveBufs NB = nv::run_naive(d_in, nullptr, nws, stream, bd, 1, 9, f1x);
    const float* z = NB.big; const float* xc = z + (size_t)nv::S * 1536; const float* pa = xc + (size_t)nv::S * 512; const float* px = pa + (size_t)nv::S * 512;
    const float* ylru = px + (size_t)nv::S * 512; const float* ys = ylru + (size_t)nv::S * 512; (void)ylru;
    auto cmp = [&](int mode, const float* ref, int rows, int cols, int ldr, const float* a0, const float* a1) {
        dbg::CmpArgs a{(const unsigned char*)d_ws, ref, a0, a1, mode, rows, cols, ldr, bd, acc};
        hipLaunchKernelGGL(dbg::k_cmp, dim3(512), dim3(256), 0, stream, a); };
    auto phase = [&](int ph) { p.ph_lo = ph; p.ph_hi = ph + 1; hipLaunchKernelGGL(fp::mega, dim3(grid), dim3(fp::NTHREADS), fp::LDS_BYTES, stream, p); };
    auto fin = (const float* const*)d_in;
    phase(0); phase(1);
    cmp(1, z, 2048, 512, 1536, nullptr, nullptr); cmp(2, z + 512, 2048, 512, 1536, nullptr, nullptr); cmp(3, z + 1024, 2048, 512, 1536, nullptr, nullptr);
    cmp(4, NB.Km, 256, 1024, 1024, nullptr, nullptr); cmp(5, NB.Vm, 256, 1024, 1024, nullptr, nullptr);
    phase(2);
    cmp(6, pa, 2048, 512, 512, nullptr, nullptr); cmp(7, px, 2048, 512, 512, nullptr, nullptr);
    phase(3); phase(4);
    cmp(8, ys, 2048, 512, 512, nullptr, nullptr); cmp(9, NB.ycat + 512, 2048, 512, 1024, fin[23], nullptr);
    phase(5);
    cmp(10, NB.ycat, 2048, 512, 1024, fin[22], nullptr);
    phase(6);
    cmp(11, NB.h1, 2048, 1024, 1024, fin[25], fin[26]);
    phase(7);
    cmp(12, NB.q, 2048, 1024, 1024, nullptr, nullptr);
    phase(8); phase(9);
    cmp(13, NB.ao, 2048, 1024, 1024, nullptr, nullptr);
    phase(10);
    cmp(14, NB.h2, 2048, 1024, 1024, fin[33], fin[34]);
    phase(11);
    cmp(15, f1x, 2048, 4096, 4096, nullptr, nullptr);
    phase(12); phase(13);
    hipLaunchKernelGGL(dbg::k_final, dim3(1), dim3(64), 0, stream, (const float*)acc, (float*)d_out, 0.03f);
#elif MK_MULTI
    for (int ph = 0; ph < fp::NPHASES; ++ph) { p.ph_lo = ph; p.ph_hi = ph + 1; hipLaunchKernelGGL(fp::mega, dim3(grid), dim3(fp::NTHREADS), fp::LDS_BYTES, stream, p); }
#else
    p.ph_lo = 0; p.ph_hi = fp::NPHASES;
    (void)hipMemsetAsync(d_ws, 0, 16384, stream);
    void* args[] = {&p};
    hipError_t e = hipLaunchCooperativeKernel((const void*)fp::mega, dim3(grid), dim3(fp::NTHREADS), args, fp::LDS_BYTES, stream);
    if (e != hipSuccess) fprintf(stderr, "cooperative launch failed: %s (grid %d)\n", hipGetErrorString(e), grid);
#endif
}
```

```cpp
#include <hip/hip_runtime.h>
#include <cstdio>
#define MK_MULTI 0
#define MK_DEBUG 0
#include <hip/hip_cooperative_groups.h>
namespace cg = cooperative_groups;
namespace fp {
#define LAS __attribute__((address_space(3)))
typedef unsigned short bf16_t;
typedef short bf16x8 __attribute__((ext_vector_type(8)));
typedef float f32x4 __attribute__((ext_vector_type(4)));
typedef float f32x2 __attribute__((ext_vector_type(2)));
typedef unsigned u32x4 __attribute__((ext_vector_type(4)));
typedef unsigned u32x2 __attribute__((ext_vector_type(2)));

constexpr int D = 1024, S = 2048, B = 16, M = B * S, DIN = 1536, DFF = 4096, MEM = 256, NG = 32, CH = 32  , NCH = S / CH  ;
constexpr float ALPHA = 1.189207115002721f;
constexpr int NTHREADS = 512;

constexpr size_t MiB = 1u << 20, KiB = 1u << 10;
constexpr size_t WS_STATS0 = 64 * KiB;
constexpr size_t WS_SSQ = 320 * KiB;
constexpr size_t WS_STATS1 = 448 * KiB;
constexpr size_t WS_STATS2 = 704 * KiB;
constexpr size_t WS_STATS3 = 960 * KiB;
constexpr size_t WS_ZERO_BEG = WS_SSQ, WS_ZERO_END = 1216 * KiB;
constexpr size_t WS_C1Q = 1216 * KiB, WS_C2Q = WS_C1Q + 4096, WS_C1F = WS_C2Q + 4096, WS_C2F = WS_C1F + 16384;
constexpr size_t WS_GBIAS = 1256 * KiB;
constexpr size_t WS_SP8 = 1260 * KiB;
constexpr size_t WS_LAML = 1264 * KiB;
constexpr size_t WS_DBG = 1300 * KiB;
constexpr size_t WS_CPART = 2 * MiB;
constexpr size_t WS_WIN = 4 * MiB;
constexpr size_t WS_WGLU = 7 * MiB;
constexpr size_t WS_WMIX = WS_WGLU + MiB / 2;
constexpr size_t WS_WQ = WS_WMIX + 2 * MiB, WS_WK = WS_WQ + 2 * MiB, WS_WV = WS_WK + 2 * MiB, WS_WO = WS_WV + 2 * MiB;
constexpr size_t WS_WF1 = WS_WO + 2 * MiB;
constexpr size_t WS_WF2 = WS_WF1 + 8 * MiB;
constexpr size_t WS_S5T = 34 * MiB + MiB / 2;
constexpr size_t WS_S5P = WS_S5T + 20 * MiB;
constexpr size_t WS_GATES = WS_S5P + 8 * MiB;
constexpr size_t WS_V1B = 64 * MiB;
constexpr size_t WS_YCAT = 128 * MiB;
constexpr size_t WS_PROB = 128 * MiB;
constexpr size_t WS_V2 = 128 * MiB;
constexpr size_t WS_KMAT = 192 * MiB;
constexpr size_t WS_VT = 200 * MiB;
constexpr size_t WS_Y1 = 208 * MiB;
constexpr size_t WS_U = 256 * MiB;
constexpr size_t WS_XL = 296 * MiB;
constexpr size_t WS_GG = 330 * MiB;
constexpr size_t WS_XEND = 362 * MiB;
constexpr size_t WS_AGG = 378 * MiB;
constexpr size_t WS_V1 = 256 * MiB;
constexpr size_t WS_H0B = 384 * MiB;
constexpr size_t WS_LA = 384 * MiB;
constexpr size_t WS_AO = 384 * MiB;
constexpr size_t WS_MEMN = 448 * MiB;
constexpr size_t WS_LB = 448 * MiB;
constexpr size_t WS_Q = 448 * MiB;
constexpr size_t WS_HDN = 256 * MiB;
constexpr size_t WS_END = 512 * MiB;
constexpr int XLROWS = S + 3;

constexpr int LDS_STAGE = 131072, LDS_X = LDS_STAGE  , LDS_BARW = LDS_STAGE + 8192  , LDS_BYTES = 147456;

__device__ __forceinline__ unsigned cvt_pk_bf16(float lo, float hi) { unsigned r; asm volatile("v_cvt_pk_bf16_f32 %0, %1, %2" : "=v"(r) : "v"(lo), "v"(hi)); return r; }
__device__ __forceinline__ bf16_t f2bf(float f) { return (bf16_t)(cvt_pk_bf16(f, 0.f) & 0xffffu); }
__device__ __forceinline__ float bf2f(unsigned short b) { return __uint_as_float(((unsigned)b) << 16); }
__device__ __forceinline__ float bflo(unsigned w) { return __uint_as_float(w << 16); }
__device__ __forceinline__ float bfhi(unsigned w) { return __uint_as_float(w & 0xffff0000u); }
__device__ __forceinline__ u32x4 pack8(f32x4 a, f32x4 b) { u32x4 w; w.x = cvt_pk_bf16(a[0], a[1]); w.y = cvt_pk_bf16(a[2], a[3]); w.z = cvt_pk_bf16(b[0], b[1]); w.w = cvt_pk_bf16(b[2], b[3]); return w; }
__device__ __forceinline__ void unpack8(u32x4 w, f32x4& a, f32x4& b) { a[0] = bflo(w.x); a[1] = bfhi(w.x); a[2] = bflo(w.y); a[3] = bfhi(w.y); b[0] = bflo(w.z); b[1] = bfhi(w.z); b[2] = bflo(w.w); b[3] = bfhi(w.w); }
__device__ __forceinline__ float fast_exp(float x) { return __builtin_amdgcn_exp2f(x * 1.4426950408889634f); }
__device__ __forceinline__ float fast_rcp(float x) { return __builtin_amdgcn_rcpf(x); }
__device__ __forceinline__ float sigm(float x) { return fast_rcp(1.0f + fast_exp(-x)); }
__device__ __forceinline__ float gelu_t(float x) {
    const float u = 0.7978845608028654f * (x + 0.044715f * x * x * x);
    return x * sigm(2.0f * u);
}
__device__ __forceinline__ float wave_sum(float v) {
#pragma unroll
    for (int o = 32; o > 0; o >>= 1) v += __shfl_xor(v, o);
    return v;
}


#define XB_TMO      128
#define XB_XCNT(j)  (256  + 64 * (j))
#define XB_XSUB(j)  (1280 + 64 * (j))
#define XB_XGEN(j)  (2304 + 64 * (j))
#define XB_TOP      3328
#define XB_TOPGEN   3392
#define XCD_BAR_WORDS 3456
#define XB_SPIN_CAP (1u << 18)
__device__ __forceinline__ unsigned xb_ld(unsigned* p)              { return __hip_atomic_load(p, __ATOMIC_RELAXED, __HIP_MEMORY_SCOPE_AGENT); }
__device__ __forceinline__ unsigned xb_add(unsigned* p, unsigned v) { return __hip_atomic_fetch_add(p, v, __ATOMIC_RELAXED, __HIP_MEMORY_SCOPE_AGENT); }
__device__ __forceinline__ unsigned xb_xcc_id() { return (unsigned)__builtin_amdgcn_s_getreg((3 << 11) | 20) & 0xFu; }
#define XB_SPIN(cond, bar) do { unsigned _sp = 0; while (cond) { __builtin_amdgcn_s_sleep(1); \
    if ((++_sp & 255u) == 0u) { if (xb_ld(&(bar)[XB_TMO])) break; if (_sp > XB_SPIN_CAP) { atomicAdd(&(bar)[XB_TMO], 1u); break; } } } } while (0)
struct XcdBarrier { unsigned* bar; unsigned x; volatile LAS unsigned* st; };
__device__ __forceinline__ XcdBarrier xcd_barrier_post(unsigned* bar, volatile LAS unsigned* st) {
    XcdBarrier b; b.bar = bar; b.x = xb_xcc_id(); b.st = st;
    if (threadIdx.x == 0) (void)xb_add(&bar[XB_XCNT(b.x)], 1u);
    return b;
}
__device__ __forceinline__ void xcd_barrier_complete(unsigned* bar, unsigned x, unsigned& nloc, unsigned& nx) {
    const unsigned G = gridDim.x * gridDim.y * gridDim.z;
    unsigned sum, cnt, mine, sp = 0u;
    for (;;) {
        sum = 0u; cnt = 0u; mine = 0u;
#pragma unroll
        for (unsigned j = 0; j < 16; ++j) { const unsigned c = xb_ld(&bar[XB_XCNT(j)]); sum += c; cnt += (c > 0u) ? 1u : 0u; mine = (j == x) ? c : mine; }
        if (sum == G) break;
        __builtin_amdgcn_s_sleep(1);
        if ((++sp & 255u) == 0u) { if (xb_ld(&bar[XB_TMO])) break; if (sp > XB_SPIN_CAP) { atomicAdd(&bar[XB_TMO], 1u); break; } }
    }
    nloc = mine > 0u ? mine : 1u; nx = cnt > 0u ? cnt : 1u;
}
__device__ __forceinline__ void xcd_barrier(const XcdBarrier& b) {
    asm volatile("s_waitcnt vmcnt(0)" ::: "memory");
    __syncthreads();
    if (threadIdx.x == 0) {
        unsigned* bar = b.bar;
        __builtin_amdgcn_s_waitcnt(0);
        unsigned nloc = b.st[0], nx = b.st[1];
        if (nloc == 0u) { xcd_barrier_complete(bar, b.x, nloc, nx); b.st[0] = nloc; b.st[1] = nx; }
        const unsigned old = xb_add(&bar[XB_XSUB(b.x)], 1u);
        const unsigned gen = old / nloc;
        if (old + 1u == (gen + 1u) * nloc) {
            __builtin_amdgcn_fence(__ATOMIC_RELEASE, "agent");
            asm volatile("s_waitcnt vmcnt(0)" ::: "memory");
            const unsigned og = xb_add(&bar[XB_TOP], 1u);
            const unsigned tg = og / nx;
            if (og + 1u == (tg + 1u) * nx) xb_add(&bar[XB_TOPGEN], 1u);
            else XB_SPIN(xb_ld(&bar[XB_TOPGEN]) == tg, bar);
            __builtin_amdgcn_fence(__ATOMIC_ACQUIRE, "agent");
            xb_add(&bar[XB_XGEN(b.x)], 1u);
            asm volatile("s_waitcnt vmcnt(0)" ::: "memory");
        } else {
            XB_SPIN(xb_ld(&bar[XB_XGEN(b.x)]) == gen, bar);
            __builtin_amdgcn_fence(__ATOMIC_ACQUIRE, "agent");
            asm volatile("s_waitcnt vmcnt(0)" ::: "memory");
        }
    }
    __syncthreads();
}

constexpr int BM = 256, BK = 64, HALF = 128, HTB = HALF * BK * 2, NXCD = 8, WGM = 8;
__device__ __forceinline__ int lds_byte(int r, int c) { const int st = (r >> 4) * 2 + (c >> 5), rr = r & 15, cc = c & 31, ob = rr * 64 + cc * 2; return st * 1024 + (ob ^ (((ob >> 9) & 1) << 5)); }
__device__ __forceinline__ void stage_rc(int b, int& R, int& C) { const int st = b / 1024, sb = b % 1024, swz = sb ^ (((sb >> 9) & 1) << 5); R = (st >> 1) * 16 + swz / 64; C = (st & 1) * 32 + (swz % 64) / 2; }
__device__ __forceinline__ int perm32(int rho) { const int n = rho >> 4, i = rho & 15; return 8 * (i >> 2) + 4 * n + (i & 3); }

struct Unit { int pm, pn, pb; };
template <int LDA, int LDB, int NT, int NM, int NN, int NB, long SAM, long SAB0, long SAB1, int BDIV, long SBN, long SBB0, long SBB1, int CONV>
struct GeomT {
    const bf16_t* A; const bf16_t* Bt;
    static constexpr int lda = LDA, ldb = LDB, nt = NT;
    static constexpr int nwg = NM * NN * NB;
    __device__ __forceinline__ bool next(int i, int G, int c, Unit& u) const {
        const int L = i * G + c; if (L >= nwg) return false;
        int wgid = L; { constexpr int q = nwg / NXCD, r = nwg % NXCD; const int xcd = wgid % NXCD, off = wgid / NXCD; wgid = (xcd < r ? xcd * (q + 1) : r * (q + 1) + (xcd - r) * q) + off; }
        constexpr int per = NM * NN; u.pb = wgid / per; const int w = wgid % per;
        constexpr int nig = WGM * NN; const int gid = w / nig, fm = gid * WGM, gsz = (NM - fm) < WGM ? (NM - fm) : WGM;
        u.pm = fm + ((w % nig) % gsz); u.pn = (w % nig) / gsz; return true;
    }
    __device__ __forceinline__ const char* abase(const Unit& u) const { return (const char*)(A + (long)u.pm * SAM + (long)(u.pb / BDIV) * SAB0 + (long)(u.pb % BDIV) * SAB1); }
    __device__ __forceinline__ const char* bbase(const Unit& u) const { return (const char*)(Bt + (long)u.pn * SBN + (long)(u.pb / BDIV) * SBB0 + (long)(u.pb % BDIV) * SBB1); }
    static __device__ __forceinline__ size_t koffA(int t) { return CONV ? ((size_t)(t >> 1) * (size_t)LDA * 2 + (size_t)(t & 1) * 128) : (size_t)t * 128; }
    static __device__ __forceinline__ size_t koffB(int t) { return (size_t)t * 128; }
};
template <int LDA, int LDB, int Mr, int Nc, int K> using PlainGeom = GeomT<LDA, LDB, K / 64, Mr / 256, Nc / 256, 1, 256L * LDA, 0, 0, 1, 256L * LDB, 0, 0, 0>;

template <class Geom, class Epi>
__device__ __forceinline__ void gemm_phase(LAS unsigned char* lds, const Geom g, const Epi& E, const int G, const int c) {
    const int tid = threadIdx.x, wid = __builtin_amdgcn_readfirstlane(tid >> 6), lane = tid & 63, wr = wid >> 2, wc = wid & 3, fr = lane & 15, fq = lane >> 4;
    constexpr int nt = Geom::nt;
    unsigned voffA[2], voffB[2];
#pragma unroll
    for (int i = 0; i < 2; ++i) { int R, C; stage_rc(tid * 16 + i * 8192, R, C); const int Rb = (R & ~31) + perm32(R & 31);
        voffA[i] = (unsigned)(R * Geom::lda + C) * 2u; voffB[i] = (unsigned)(Rb * Geom::ldb + C) * 2u; }
    constexpr size_t hstepA = (size_t)HALF * Geom::lda * 2, hstepB = (size_t)HALF * Geom::ldb * 2;
    const unsigned ldsw = (unsigned)wid * 1024u;
    const int aoff = lds_byte(wr * 64 + fr, fq * 8), boff = lds_byte(wc * 32 + fr, fq * 8);
#define PG8_SA(b, h) (((b) * 2 + (h)) * HTB)
#define PG8_SB(b, h) ((4 + (b) * 2 + (h)) * HTB)
#define PG8_STAGE(bufoff, gbase, voff) do { _Pragma("unroll") for (int _i = 0; _i < 2; ++_i) \
        __builtin_amdgcn_global_load_lds((const unsigned*)((const char*)(gbase) + (voff)[_i]), (LAS unsigned*)(lds + (bufoff) + ldsw + _i * 8192), 16, 0, 0); } while (0)
#define PG8_LDA(dst, b, h) do { _Pragma("unroll") for (int m = 0; m < 4; ++m) _Pragma("unroll") for (int k = 0; k < 2; ++k) dst[m][k] = *(const LAS bf16x8*)(lds + PG8_SA(b, h) + aoff + m * 2048 + k * 1024); } while (0)
#define PG8_LDB(dst, b, h) do { _Pragma("unroll") for (int n = 0; n < 2; ++n) _Pragma("unroll") for (int k = 0; k < 2; ++k) dst[n][k] = *(const LAS bf16x8*)(lds + PG8_SB(b, h) + boff + n * 2048 + k * 1024); } while (0)
#define PG8_MMA(ai, bj, At, Bt) do { __builtin_amdgcn_s_setprio(1); _Pragma("unroll") for (int m = 0; m < 4; ++m) _Pragma("unroll") for (int n = 0; n < 2; ++n) _Pragma("unroll") for (int k = 0; k < 2; ++k) \
        acc[ai][bj][m][n] = __builtin_amdgcn_mfma_f32_16x16x32_bf16(Bt[n][k], At[m][k], acc[ai][bj][m][n], 0, 0, 0); __builtin_amdgcn_s_setprio(0); } while (0)
#define PG8_WAIT_V(n) asm volatile("s_waitcnt vmcnt(" #n ")" ::: "memory")
#define PG8_WAIT_L(n) asm volatile("s_waitcnt lgkmcnt(" #n ")" ::: "memory")
#define PG8_BAR __builtin_amdgcn_s_barrier()
#define PG8_SCHED __builtin_amdgcn_sched_barrier(0)
    Unit cur, nxt; int ui = 0;
    if (!g.next(0, G, c, cur)) return;
    f32x4 acc[2][2][4][2];
#pragma unroll
    for (int a = 0; a < 2; ++a)
#pragma unroll
        for (int b = 0; b < 2; ++b)
#pragma unroll
            for (int m = 0; m < 4; ++m)
#pragma unroll
                for (int n = 0; n < 2; ++n) acc[a][b][m][n] = (f32x4){0.f, 0.f, 0.f, 0.f};
    bf16x8 At[4][2], B0[2][2], B1[2][2];
    const char* cA = g.abase(cur); const char* cB = g.bbase(cur);
    PG8_STAGE(PG8_SB(0, 0), cB, voffB); PG8_STAGE(PG8_SB(0, 1), cB + hstepB, voffB); PG8_STAGE(PG8_SA(0, 0), cA, voffA); PG8_STAGE(PG8_SA(0, 1), cA + hstepA, voffA);
    if (wr == 1) PG8_BAR;
    PG8_WAIT_V(2); PG8_BAR;
    PG8_STAGE(PG8_SB(1, 0), cB + g.koffB(1), voffB); PG8_STAGE(PG8_SA(1, 0), cA + g.koffA(1), voffA); PG8_STAGE(PG8_SB(1, 1), cB + hstepB + g.koffB(1), voffB);
    PG8_WAIT_V(6); PG8_BAR;
    for (;;) {
        const bool has_next = g.next(ui + 1, G, c, nxt);
        const char* nA = has_next ? g.abase(nxt) : cA; const char* nB = has_next ? g.bbase(nxt) : cB;
#pragma nounroll
        for (int t = 0; t < nt; t += 2) {
            const bool last = (t == nt - 2);
            const char* a1 = cA + g.koffA(t + 1);
            const char* a2 = last ? nA : cA + g.koffA(t + 2); const char* b2 = last ? nB : cB + g.koffB(t + 2);
            const char* a3 = last ? nA + g.koffA(1) : cA + g.koffA(t + 3); const char* b3 = last ? nB + g.koffB(1) : cB + g.koffB(t + 3);
            if constexpr (Epi::MIDK >= 0) { if (t == Epi::MIDK) E.midk(acc, cur, wr, wc, fr, fq); }
            PG8_LDB(B0, 0, 0); PG8_LDB(B1, 0, 1); PG8_SCHED; PG8_LDA(At, 0, 0); PG8_STAGE(PG8_SA(1, 1), a1 + hstepA, voffA);
            PG8_WAIT_V(8); PG8_WAIT_L(0); PG8_BAR; PG8_MMA(0, 0, At, B0); PG8_MMA(0, 1, At, B1); PG8_BAR; PG8_SCHED;
            PG8_LDA(At, 0, 1); PG8_STAGE(PG8_SB(0, 0), b2, voffB); PG8_STAGE(PG8_SB(0, 1), b2 + hstepB, voffB); PG8_STAGE(PG8_SA(0, 0), a2, voffA);
            PG8_WAIT_V(8); PG8_WAIT_L(0); PG8_BAR; PG8_MMA(1, 0, At, B0); PG8_MMA(1, 1, At, B1); PG8_BAR; PG8_SCHED;
            PG8_LDB(B0, 1, 0); PG8_LDB(B1, 1, 1); PG8_SCHED; PG8_LDA(At, 1, 0); PG8_STAGE(PG8_SA(0, 1), a2 + hstepA, voffA);
            PG8_WAIT_V(8); PG8_WAIT_L(0); PG8_BAR; PG8_MMA(0, 0, At, B0); PG8_MMA(0, 1, At, B1); PG8_BAR; PG8_SCHED;
            PG8_LDA(At, 1, 1); PG8_STAGE(PG8_SB(1, 0), b3, voffB); PG8_STAGE(PG8_SB(1, 1), b3 + hstepB, voffB); PG8_STAGE(PG8_SA(1, 0), a3, voffA);
            PG8_WAIT_V(8); PG8_WAIT_L(0); PG8_BAR; PG8_MMA(1, 0, At, B0); PG8_MMA(1, 1, At, B1); PG8_BAR; PG8_SCHED;
        }
        if (wr == 0) PG8_BAR;
        E(acc, cur, wr, wc, fr, fq, lds);
        if (!has_next) break;
#pragma unroll
        for (int a = 0; a < 2; ++a)
#pragma unroll
            for (int b = 0; b < 2; ++b)
#pragma unroll
                for (int m = 0; m < 4; ++m)
#pragma unroll
                    for (int n = 0; n < 2; ++n) acc[a][b][m][n] = (f32x4){0.f, 0.f, 0.f, 0.f};
        cur = nxt; cA = nA; cB = nB; ++ui;
        if (wr == 1) PG8_BAR;
    }
    PG8_WAIT_V(0);
    PG8_BAR;
#undef PG8_SA
#undef PG8_SB
#undef PG8_STAGE
#undef PG8_LDA
#undef PG8_LDB
#undef PG8_MMA
#undef PG8_WAIT_V
#undef PG8_WAIT_L
#undef PG8_BAR
#undef PG8_SCHED
}
#define EPI_ARGS f32x4 (&acc)[2][2][4][2], const Unit& u, int wr, int wc, int fr, int fq
struct EpiBase { static constexpr int MIDK = -1; __device__ __forceinline__ void midk(EPI_ARGS) const {} };

struct EpiZ : EpiBase {
    bf16_t* U; bf16_t* XL; bf16_t* GG;
    __device__ __forceinline__ void operator()(EPI_ARGS, LAS unsigned char*) const {
        const int row0 = u.pm * BM + wr * 64 + fr;
#pragma unroll
        for (int ai = 0; ai < 2; ++ai)
#pragma unroll
            for (int m = 0; m < 4; ++m) {
                const int r = row0 + ai * HALF + m * 16, b = r >> 11, t = r & 2047;
#pragma unroll
                for (int bj = 0; bj < 2; ++bj) {
                    const int c = u.pn * BM + bj * HALF + wc * 32 + fq * 8;
                    f32x4 v0 = acc[ai][bj][m][0], v1 = acc[ai][bj][m][1];
                    if (u.pn < 2) {
                        const int g = c >> 4, hi0 = c & 15;
                        *(u32x4*)(U + ((size_t)(g * 1024 + b * NCH + (t >> 5)) * 640 + (t & 31) * 16 + hi0)) = pack8(v0, v1);
                    } else if (u.pn < 4) {
                        *(u32x4*)(XL + ((size_t)(b * XLROWS + 3 + t) * 512 + (c - 512))) = pack8(v0, v1);
                    } else {
#pragma unroll
                        for (int j = 0; j < 4; ++j) { v0[j] = gelu_t(v0[j]); v1[j] = gelu_t(v1[j]); }
                        *(u32x4*)(GG + ((size_t)r * 512 + (c - 1024))) = pack8(v0, v1);
                    }
                }
                asm volatile("" ::: "memory");
            }
    }
};
struct EpiBf16 : EpiBase {
    bf16_t* O; int ldc; int bdiv; long ob0, ob1;
    __device__ __forceinline__ void operator()(EPI_ARGS, LAS unsigned char*) const {
        bf16_t* base = O + (long)(u.pb / bdiv) * ob0 + (long)(u.pb % bdiv) * ob1;
        const int row0 = u.pm * BM + wr * 64 + fr;
#pragma unroll
        for (int ai = 0; ai < 2; ++ai)
#pragma unroll
            for (int m = 0; m < 4; ++m) {
                bf16_t* rowp = base + (size_t)(row0 + ai * HALF + m * 16) * ldc + u.pn * BM + wc * 32 + fq * 8;
#pragma unroll
                for (int bj = 0; bj < 2; ++bj) *(u32x4*)(rowp + bj * HALF) = pack8(acc[ai][bj][m][0], acc[ai][bj][m][1]);
            }
    }
};
struct EpiXend : EpiBase {
    float* X;
    __device__ __forceinline__ void operator()(EPI_ARGS, LAS unsigned char*) const {
        const int row0 = u.pm * BM + wr * 64 + fr;
#pragma unroll
        for (int ai = 0; ai < 2; ++ai)
#pragma unroll
            for (int m = 0; m < 4; ++m) {
                float* rowp = X + ((size_t)u.pb * 1024 + row0 + ai * HALF + m * 16) * 128 + wc * 32 + fq * 8;
                *(f32x4*)(rowp) = acc[ai][0][m][0]; *(f32x4*)(rowp + 4) = acc[ai][0][m][1];
            }
    }
};
struct EpiGates : EpiBase {
    const bf16_t* XL; const float* cw; const float* cb; const float* gbias; const float* sp8; float* LA; float* LB;
    __device__ __forceinline__ void operator()(EPI_ARGS, LAS unsigned char*) const {
        const int hp = u.pb >> 4, b = u.pb & 15, rt = u.pm;
        const int ch0 = hp * 128 + wc * 32 + fq * 8;
        const float* gb = gbias + hp * 256 + wc * 32 + fq * 8;
#pragma unroll
        for (int ai = 0; ai < 2; ++ai)
#pragma unroll
            for (int m = 0; m < 4; ++m) {
                const int t = rt * 256 + ai * HALF + wr * 64 + m * 16 + fr;
                const bf16_t* xr = XL + ((size_t)(b * XLROWS + t) * 512 + ch0);
                const size_t o = ((size_t)(b * S + t)) * 512 + ch0;
#pragma unroll
                for (int n = 0; n < 2; ++n) {
                    f32x4 xc = *(const f32x4*)(cb + ch0 + 4 * n);
#pragma unroll
                    for (int k = 0; k < 4; ++k) { const u32x2 wv = *(const u32x2*)(xr + (size_t)k * 512 + 4 * n); const f32x4 w = *(const f32x4*)(cw + k * 512 + ch0 + 4 * n);
                        xc[0] += w[0] * bflo(wv.x); xc[1] += w[1] * bfhi(wv.x); xc[2] += w[2] * bflo(wv.y); xc[3] += w[3] * bfhi(wv.y); }
                    const f32x4 ba = *(const f32x4*)(gb + 4 * n), bx = *(const f32x4*)(gb + 128 + 4 * n), spv = *(const f32x4*)(sp8 + ch0 + 4 * n);
                    f32x4 av, bv;
#pragma unroll
                    for (int j = 0; j < 4; ++j) {
                        const float r = sigm(acc[ai][0][m][n][j] + ba[j]), ig = sigm(acc[ai][1][m][n][j] + bx[j]);
                        const float la = -r * spv[j];
                        const float a = fast_exp(la);
                        const float x2 = 2.0f * la;
                        const float om = (x2 > -0.1f) ? (-x2 * (1.0f + x2 * (0.5f + x2 * (0.16666667f + x2 * 0.041666668f)))) : (1.0f - a * a);
                        av[j] = a; bv[j] = __builtin_sqrtf(om) * ig * xc[j];
                    }
                    *(f32x4*)(LA + o + 4 * n) = av; *(f32x4*)(LB + o + 4 * n) = bv;
                    asm volatile("" ::: "memory");
                }
            }
    }
};
struct EpiS5 : EpiBase {
    const bf16_t* U; const float* dd; bf16_t* Y1;
    __device__ __forceinline__ void operator()(EPI_ARGS, LAS unsigned char*) const {
        const int g = u.pb; const int row0 = u.pm * BM + wr * 64 + fr;
#pragma unroll
        for (int bj = 0; bj < 2; ++bj) {
            const int c = u.pn * BM + bj * HALF + wc * 32 + fq * 8, i = c >> 4, ho0 = c & 15;
            const f32x4 d0 = *(const f32x4*)(dd + g * 16 + ho0), d1 = *(const f32x4*)(dd + g * 16 + ho0 + 4);
#pragma unroll
            for (int ai = 0; ai < 2; ++ai)
#pragma unroll
                for (int m = 0; m < 4; ++m) {
                    const int R = row0 + ai * HALF + m * 16, b = R >> 6, chn = R & 63;
                    const u32x4 uw = *(const u32x4*)(U + ((size_t)(g * 1024 + R) * 640 + c)); f32x4 u0, u1; unpack8(uw, u0, u1);
                    f32x4 v0 = acc[ai][bj][m][0] + d0 * u0, v1 = acc[ai][bj][m][1] + d1 * u1;
#pragma unroll
                    for (int j = 0; j < 4; ++j) { v0[j] = gelu_t(v0[j]); v1[j] = gelu_t(v1[j]); }
                    *(u32x4*)(Y1 + ((size_t)(b * S + chn * CH + i) * 512 + g * 16 + ho0)) = pack8(v0, v1);
                    asm volatile("" ::: "memory");
                }
        }
    }
};
struct EpiGlu : EpiBase {
    const bf16_t* Y1; const float* bg; bf16_t* YC; float* ssq;
    __device__ __forceinline__ void operator()(EPI_ARGS, LAS unsigned char*) const {
        const int row0 = u.pm * BM + wr * 64 + fr;
        float ss[2][4];
#pragma unroll
        for (int ai = 0; ai < 2; ++ai)
#pragma unroll
            for (int m = 0; m < 4; ++m) ss[ai][m] = 0.f;
#pragma unroll
        for (int bj = 0; bj < 2; ++bj) {
            const int c = u.pn * BM + bj * HALF + wc * 32 + fq * 8;
            const f32x4 g0 = *(const f32x4*)(bg + c), g1 = *(const f32x4*)(bg + c + 4);
#pragma unroll
            for (int ai = 0; ai < 2; ++ai)
#pragma unroll
                for (int m = 0; m < 4; ++m) {
                    const size_t r = row0 + ai * HALF + m * 16;
                    const u32x4 yw = *(const u32x4*)(Y1 + r * 512 + c); f32x4 y0, y1; unpack8(yw, y0, y1);
                    f32x4 v0, v1;
#pragma unroll
                    for (int j = 0; j < 4; ++j) { v0[j] = y0[j] * sigm(acc[ai][bj][m][0][j] + g0[j]); v1[j] = y1[j] * sigm(acc[ai][bj][m][1][j] + g1[j]); ss[ai][m] += v0[j] * v0[j] + v1[j] * v1[j]; }
                    *(u32x4*)(YC + r * 1024 + c) = pack8(v0, v1);
                    asm volatile("" ::: "memory");
                }
        }
#pragma unroll
        for (int ai = 0; ai < 2; ++ai)
#pragma unroll
            for (int m = 0; m < 4; ++m) { float s = ss[ai][m]; s += __shfl_xor(s, 16); s += __shfl_xor(s, 32); if (fq == 0) atomicAdd(ssq + row0 + ai * HALF + m * 16, s); }
    }
};
template <int MODE, bool HASB, int MK>
struct EpiRes {
    static constexpr int MIDK = MK;
    const float* prev; const float* pstats; const float* pg; const float* pb_; float* vout; bf16_t* vb; float* ostats; const float* ssq;
    __device__ __forceinline__ void midk(EPI_ARGS) const {
        const int row0 = u.pm * BM + wr * 64 + fr;
#pragma unroll
        for (int ai = 0; ai < 2; ++ai)
#pragma unroll
            for (int m = 0; m < 4; ++m) { const float s = __builtin_amdgcn_rsqf(ssq[row0 + ai * HALF + m * 16] * (1.0f / 512.0f) + 1e-6f);
#pragma unroll
                for (int bj = 0; bj < 2; ++bj)
#pragma unroll
                    for (int n = 0; n < 2; ++n) acc[ai][bj][m][n] = acc[ai][bj][m][n] * s; }
    }
    __device__ __forceinline__ void operator()(EPI_ARGS, LAS unsigned char*) const {
        const int row0 = u.pm * BM + wr * 64 + fr;
        float s1[2][4], s2[2][4];
#pragma unroll
        for (int ai = 0; ai < 2; ++ai)
#pragma unroll
            for (int m = 0; m < 4; ++m) { s1[ai][m] = 0.f; s2[ai][m] = 0.f; }
#pragma unroll
        for (int bj = 0; bj < 2; ++bj) {
            const int c = u.pn * BM + bj * HALF + wc * 32 + fq * 8;
            const f32x4 g0 = *(const f32x4*)(pg + c), g1 = *(const f32x4*)(pg + c + 4), b0 = *(const f32x4*)(pb_ + c), b1 = *(const f32x4*)(pb_ + c + 4);
#pragma unroll
            for (int ai = 0; ai < 2; ++ai)
#pragma unroll
                for (int m = 0; m < 4; ++m) {
                    const int r = row0 + ai * HALF + m * 16;
                    const f32x2 st = *(const f32x2*)(pstats + 2 * (size_t)r);
                    float mm, rr;
                    if (MODE == 0) { mm = st.x; rr = st.y; }
                    else { mm = st.x * (1.0f / 1024.0f); rr = __builtin_amdgcn_rsqf(st.y * (1.0f / 1024.0f) - mm * mm + 1e-5f); }
                    const size_t o = (size_t)r * 1024 + c;
                    const f32x4 p0 = *(const f32x4*)(prev + o), p1 = *(const f32x4*)(prev + o + 4);
                    const f32x4 v0 = ((p0 - mm) * rr * g0 + b0) * ALPHA + acc[ai][bj][m][0], v1 = ((p1 - mm) * rr * g1 + b1) * ALPHA + acc[ai][bj][m][1];
                    *(f32x4*)(vout + o) = v0; *(f32x4*)(vout + o + 4) = v1;
                    if (HASB) *(u32x4*)(vb + o) = pack8(v0, v1);
#pragma unroll
                    for (int j = 0; j < 4; ++j) { s1[ai][m] += v0[j] + v1[j]; s2[ai][m] += v0[j] * v0[j] + v1[j] * v1[j]; }
                    asm volatile("" ::: "memory");
                }
        }
#pragma unroll
        for (int ai = 0; ai < 2; ++ai)
#pragma unroll
            for (int m = 0; m < 4; ++m) { float a = s1[ai][m], q = s2[ai][m]; a += __shfl_xor(a, 16); a += __shfl_xor(a, 32); q += __shfl_xor(q, 16); q += __shfl_xor(q, 32);
                if (fq == 0) { float* d = ostats + 2 * (size_t)(row0 + ai * HALF + m * 16); atomicAdd(d, a); atomicAdd(d + 1, q); } }
    }
};
template <int ACT>
struct EpiFold : EpiBase {
    const float* pstats; const float* c1; const float* c2; bf16_t* O; int ldc; float sc;
    __device__ __forceinline__ void operator()(EPI_ARGS, LAS unsigned char*) const {
        const int row0 = u.pm * BM + wr * 64 + fr;
        float mu[2][4], rs[2][4];
#pragma unroll
        for (int ai = 0; ai < 2; ++ai)
#pragma unroll
            for (int m = 0; m < 4; ++m) { const f32x2 st = *(const f32x2*)(pstats + 2 * (size_t)(row0 + ai * HALF + m * 16));
                const float mm = st.x * (1.0f / 1024.0f); mu[ai][m] = mm; rs[ai][m] = __builtin_amdgcn_rsqf(st.y * (1.0f / 1024.0f) - mm * mm + 1e-5f); }
#pragma unroll
        for (int bj = 0; bj < 2; ++bj) {
            const int c = u.pn * BM + bj * HALF + wc * 32 + fq * 8;
            const f32x4 k0 = *(const f32x4*)(c1 + c), k1 = *(const f32x4*)(c1 + c + 4), e0 = *(const f32x4*)(c2 + c), e1 = *(const f32x4*)(c2 + c + 4);
#pragma unroll
            for (int ai = 0; ai < 2; ++ai)
#pragma unroll
                for (int m = 0; m < 4; ++m) {
                    const float mm = mu[ai][m], rr = rs[ai][m];
                    f32x4 v0 = (acc[ai][bj][m][0] - k0 * mm) * rr + e0, v1 = (acc[ai][bj][m][1] - k1 * mm) * rr + e1;
                    if (ACT == 0) { v0 = v0 * sc; v1 = v1 * sc; }
                    else {
#pragma unroll
                        for (int j = 0; j < 4; ++j) { const float a = fmaxf(v0[j], 0.f), b = fmaxf(v1[j], 0.f); v0[j] = a * a; v1[j] = b * b; } }
                    *(u32x4*)(O + (size_t)(row0 + ai * HALF + m * 16) * ldc + c) = pack8(v0, v1);
                    asm volatile("" ::: "memory");
                }
        }
    }
};
struct EpiSoftmax : EpiBase {
    bf16_t* P;
    __device__ __forceinline__ void operator()(EPI_ARGS, LAS unsigned char* lds) const {
        LAS f32x2* X = (LAS f32x2*)(lds + LDS_X);
        float mw[2][4];
#pragma unroll
        for (int ai = 0; ai < 2; ++ai)
#pragma unroll
            for (int m = 0; m < 4; ++m) {
                float mx = -3.0e38f;
#pragma unroll
                for (int bj = 0; bj < 2; ++bj)
#pragma unroll
                    for (int n = 0; n < 2; ++n)
#pragma unroll
                        for (int j = 0; j < 4; ++j) mx = fmaxf(mx, acc[ai][bj][m][n][j]);
                mx = fmaxf(mx, __shfl_xor(mx, 16)); mx = fmaxf(mx, __shfl_xor(mx, 32));
                float sm = 0.f;
#pragma unroll
                for (int bj = 0; bj < 2; ++bj)
#pragma unroll
                    for (int n = 0; n < 2; ++n)
#pragma unroll
                        for (int j = 0; j < 4; ++j) { const float e = fast_exp(acc[ai][bj][m][n][j] - mx); acc[ai][bj][m][n][j] = e; sm += e; }
                sm += __shfl_xor(sm, 16); sm += __shfl_xor(sm, 32);
                mw[ai][m] = mx;
                if (fq == 0) X[(ai * HALF + wr * 64 + m * 16 + fr) * 4 + wc] = (f32x2){mx, sm};
            }
        asm volatile("s_waitcnt lgkmcnt(0)" ::: "memory"); __builtin_amdgcn_s_barrier(); asm volatile("" ::: "memory");
        const int row0 = u.pm * BM + wr * 64 + fr;
#pragma unroll
        for (int ai = 0; ai < 2; ++ai)
#pragma unroll
            for (int m = 0; m < 4; ++m) {
                const int rl = ai * HALF + wr * 64 + m * 16 + fr;
                const f32x2 x0 = X[rl * 4 + 0], x1 = X[rl * 4 + 1], x2 = X[rl * 4 + 2], x3 = X[rl * 4 + 3];
                const float Mx = fmaxf(fmaxf(x0.x, x1.x), fmaxf(x2.x, x3.x));
                const float tot = x0.y * fast_exp(x0.x - Mx) + x1.y * fast_exp(x1.x - Mx) + x2.y * fast_exp(x2.x - Mx) + x3.y * fast_exp(x3.x - Mx);
                const float scl = fast_exp(mw[ai][m] - Mx) * fast_rcp(tot);
                bf16_t* rowp = P + ((size_t)u.pb * S + row0 + ai * HALF + m * 16) * 256 + wc * 32 + fq * 8;
#pragma unroll
                for (int bj = 0; bj < 2; ++bj) *(u32x4*)(rowp + bj * HALF) = pack8(acc[ai][bj][m][0] * scl, acc[ai][bj][m][1] * scl);
            }
        asm volatile("s_waitcnt lgkmcnt(0)" ::: "memory");
    }
};
struct Params { const float* in[39]; float* out; unsigned char* ws; int ph_lo, ph_hi; };
typedef const Params __attribute__((address_space(4)))* KP;
__device__ __forceinline__ KP kargs() { KP q = (KP)__builtin_amdgcn_kernarg_segment_ptr(); asm volatile("" : "+s"(q)); return q; }

__device__ __forceinline__ void p0_tile_wave(const float* __restrict__ W, int K, int N, const float* sA, const float* sB, int split, const float* lb, float* c1p, float* c2p,
                                             bf16_t* __restrict__ Wt, int tile, LAS float* scr, int lane) {
    const int tiles_n = N >> 6, tk = tile / tiles_n, tn = tile % tiles_n, k0 = tk * 64, n0 = tn * 64;
    f32x4 v[16];
#pragma unroll
    for (int i = 0; i < 16; ++i) v[i] = *(const f32x4*)(W + (size_t)(k0 + i * 4 + (lane >> 4)) * N + n0 + (lane & 15) * 4);
#pragma unroll
    for (int i = 0; i < 16; ++i) { LAS float* d = scr + (i * 4 + (lane >> 4)) * 65 + (lane & 15) * 4; d[0] = v[i][0]; d[1] = v[i][1]; d[2] = v[i][2]; d[3] = v[i][3]; }
    asm volatile("s_waitcnt lgkmcnt(0)" ::: "memory");
    const int kc = lane & 7, kb = k0 + kc * 8;
    f32x4 s0 = (f32x4){1.f, 1.f, 1.f, 1.f}, s1 = s0;
    if (sA) { const float* sp = (kb < split) ? (sA + kb) : (sB + (kb - split)); s0 = *(const f32x4*)sp; s1 = *(const f32x4*)(sp + 4); }
    f32x4 l0 = (f32x4){0.f, 0.f, 0.f, 0.f}, l1 = l0;
    if (lb) { l0 = *(const f32x4*)(lb + kb); l1 = *(const f32x4*)(lb + kb + 4); }
#pragma unroll
    for (int ps = 0; ps < 8; ++ps) {
        const int n = ps * 8 + (lane >> 3); f32x4 a, b;
#pragma unroll
        for (int j = 0; j < 4; ++j) { a[j] = scr[(kc * 8 + j) * 65 + n]; b[j] = scr[(kc * 8 + 4 + j) * 65 + n]; }
        const f32x4 as = a * s0, bs = b * s1; const u32x4 w = pack8(as, bs);
        *(u32x4*)(Wt + (size_t)(n0 + n) * K + kb) = w;
        if (lb) {
            f32x4 ra, rb; unpack8(w, ra, rb);
            float c1 = (ra[0] + ra[1]) + (ra[2] + ra[3]) + (rb[0] + rb[1]) + (rb[2] + rb[3]);
            float c2 = (a[0] * l0[0] + a[1] * l0[1]) + (a[2] * l0[2] + a[3] * l0[3]) + (b[0] * l1[0] + b[1] * l1[1]) + (b[2] * l1[2] + b[3] * l1[3]);
            c1 += __shfl_xor(c1, 1); c1 += __shfl_xor(c1, 2); c1 += __shfl_xor(c1, 4); c2 += __shfl_xor(c2, 1); c2 += __shfl_xor(c2, 2); c2 += __shfl_xor(c2, 4);
            if (kc == 0) { c1p[(size_t)tk * N + n0 + n] = c1; c2p[(size_t)tk * N + n0 + n] = c2; }
        }
    }
    asm volatile("s_waitcnt lgkmcnt(0)" ::: "memory");
}
__device__ __forceinline__ void p0_ln_rows(KP p, unsigned char* ws, int V, int NV, int lane) {
    constexpr int NR = M + 4096;
    const float* xin = p->in[0]; const float* min_ = p->in[1];
    auto src = [&](int r) -> const float* { return r < M ? xin + (size_t)r * 1024 : min_ + (size_t)(r - M) * 1024; };
    if (V >= NR) return;
    f32x4 nv[4];
#pragma unroll
    for (int j = 0; j < 4; ++j) nv[j] = *(const f32x4*)(src(V) + j * 256 + lane * 4);
    for (int r = V; r < NR; r += NV) {
        f32x4 v[4];
#pragma unroll
        for (int j = 0; j < 4; ++j) v[j] = nv[j];
        const int rn = r + NV;
        if (rn < NR) {
#pragma unroll
            for (int j = 0; j < 4; ++j) nv[j] = *(const f32x4*)(src(rn) + j * 256 + lane * 4); }
        float s = 0.f;
#pragma unroll
        for (int j = 0; j < 4; ++j) s += (v[j][0] + v[j][1]) + (v[j][2] + v[j][3]);
        const float mu = wave_sum(s) * (1.0f / 1024.0f); float q = 0.f;
#pragma unroll
        for (int j = 0; j < 4; ++j) { v[j] = v[j] - mu; q += (v[j][0] * v[j][0] + v[j][1] * v[j][1]) + (v[j][2] * v[j][2] + v[j][3] * v[j][3]); }
        const float rstd = rsqrtf(wave_sum(q) * (1.0f / 1024.0f) + 1e-5f);
        const bool isx = r < M; const float* g = isx ? p->in[2] : p->in[27]; const float* b = isx ? p->in[3] : p->in[28];
        bf16_t* o = isx ? (bf16_t*)(ws + WS_H0B) + (size_t)r * 1024 : (bf16_t*)(ws + WS_MEMN) + (size_t)(r - M) * 1024;
#pragma unroll
        for (int j = 0; j < 4; ++j) { const f32x4 gg = *(const f32x4*)(g + j * 256 + lane * 4), bb = *(const f32x4*)(b + j * 256 + lane * 4); const f32x4 y = v[j] * rstd * gg + bb;
            u32x2 w; w.x = cvt_pk_bf16(y[0], y[1]); w.y = cvt_pk_bf16(y[2], y[3]); *(u32x2*)(o + j * 256 + lane * 4) = w; }
        if (isx && lane == 0) { float* st = (float*)(ws + WS_STATS0) + 2 * (size_t)r; st[0] = mu; st[1] = rstd; }
    }
}
__device__ __forceinline__ void p0_s5_tables(KP p, int g, LAS unsigned char* lds, int tid) {
    LAS float* lam = (LAS float*)lds;
    LAS float* Bb = lam + 33 * 128;
    LAS float* Cc = Bb + 2048;
    LAS float* Kt = Cc + 2048;
    const float* a_re = p->in[5] + g * 64; const float* a_im = p->in[6] + g * 64; const float dt = expf(p->in[7][g]);
    for (int i = tid; i < 33 * 64; i += NTHREADS) { const int tau = i >> 6, pp = i & 63; const float mag = expf((float)tau * dt * a_re[pp]); float sn, cs; sincosf((float)tau * dt * a_im[pp], &sn, &cs);
        lam[i * 2] = mag * cs; lam[i * 2 + 1] = mag * sn; }
    for (int i = tid; i < 1024; i += NTHREADS) { const int pp = i >> 4, h = i & 15;
        const float ar = a_re[pp], ai = a_im[pp]; const float mag = expf(dt * ar); float sn, cs; sincosf(dt * ai, &sn, &cs); const float lr = mag * cs, li = mag * sn;
        const float den = ar * ar + ai * ai; const float qr = ((lr - 1.f) * ar + li * ai) / den, qi = (li * ar - (lr - 1.f) * ai) / den;
        const float br = p->in[8][(g * 64 + pp) * 16 + h], bi = p->in[9][(g * 64 + pp) * 16 + h];
        Bb[i * 2] = qr * br - qi * bi; Bb[i * 2 + 1] = qr * bi + qi * br;
        const int ho = i >> 6, p2 = i & 63; Cc[i * 2] = p->in[10][(g * 16 + ho) * 64 + p2]; Cc[i * 2 + 1] = p->in[11][(g * 16 + ho) * 64 + p2]; }
    __syncthreads();
    { const int e = tid >> 1, ho = e >> 4, hi = e & 15, half = tid & 1;
      f32x2 cb[32];
#pragma unroll
      for (int q = 0; q < 32; ++q) { const int pp = half * 32 + q; const f32x2 cc = *(LAS f32x2*)(Cc + (ho * 64 + pp) * 2), bb = *(LAS f32x2*)(Bb + (pp * 16 + hi) * 2);
          cb[q] = (f32x2){cc.x * bb.x - cc.y * bb.y, cc.x * bb.y + cc.y * bb.x}; }
      for (int tau = 0; tau < 32; ++tau) { float s = 0.f;
#pragma unroll
          for (int q = 0; q < 32; ++q) { const f32x2 l = *(LAS f32x2*)(lam + (tau * 64 + half * 32 + q) * 2); s += cb[q].x * l.x - cb[q].y * l.y; }
          s += __shfl_xor(s, 1); if (half == 0) Kt[tau * 256 + e] = s; } }
    __syncthreads();
    bf16_t* T = (bf16_t*)(p->ws + WS_S5T) + (size_t)g * 512 * 640;
    for (int q = tid; q < 512 * 80; q += NTHREADS) { const int n = q / 80, kc = q % 80, i = n >> 4, ho = n & 15; f32x4 a, b;
        if (kc < 64) { const int j = kc >> 1, hi0 = (kc & 1) * 8;
            if (i >= j) { LAS float* src = Kt + (i - j) * 256 + ho * 16 + hi0; a = *(LAS f32x4*)src; b = *(LAS f32x4*)(src + 4); }
            else { a = (f32x4){0.f, 0.f, 0.f, 0.f}; b = a; } }
        else { const int p0 = (kc - 64) * 4;
#pragma unroll
            for (int x = 0; x < 4; ++x) { const int pp = p0 + x; const float cr = Cc[(ho * 64 + pp) * 2], ci = Cc[(ho * 64 + pp) * 2 + 1], lr = lam[((i + 1) * 64 + pp) * 2], li = lam[((i + 1) * 64 + pp) * 2 + 1];
                const float re = cr * lr - ci * li, im = cr * li + ci * lr; if (x < 2) { a[2 * x] = re; a[2 * x + 1] = -im; } else { b[2 * (x - 2)] = re; b[2 * (x - 2) + 1] = -im; } } }
        *(u32x4*)(T + (size_t)n * 640 + kc * 8) = pack8(a, b); }
    bf16_t* Pm = (bf16_t*)(p->ws + WS_S5P) + (size_t)g * 256 * 512;
    for (int q = tid; q < 256 * 64; q += NTHREADS) { const int n = q >> 6, kc = q & 63; f32x4 a = (f32x4){0.f, 0.f, 0.f, 0.f}, b = a;
        if (n < 128) { const int pp = n >> 1, im = n & 1, j = kc >> 1, hi0 = (kc & 1) * 8; const float lr = lam[((CH - 1 - j) * 64 + pp) * 2], li = lam[((CH - 1 - j) * 64 + pp) * 2 + 1];
#pragma unroll
            for (int x = 0; x < 8; ++x) { const float br = Bb[(pp * 16 + hi0 + x) * 2], bi = Bb[(pp * 16 + hi0 + x) * 2 + 1]; const float v = im ? (lr * bi + li * br) : (lr * br - li * bi); if (x < 4) a[x] = v; else b[x - 4] = v; } }
        *(u32x4*)(Pm + (size_t)n * 512 + kc * 8) = pack8(a, b); }
    if (tid < 128) ((float*)(p->ws + WS_LAML))[g * 128 + tid] = lam[CH * 128 + tid];
    __syncthreads();
}
__device__ __forceinline__ void p0_prep(KP p, LAS unsigned char* lds, int G, int c) {
    const int tid = threadIdx.x, lane = tid & 63, wave = tid >> 6;
    unsigned char* ws = p->ws;
    const int NS = (G > 64) ? 32 : 0;
    if (c < NS || NS == 0) {
        constexpr int I_GT = 128, I_GB = 2, I_SP = 1, I_Z = 112 + 6, NSM = I_GT + I_GB + I_SP + I_Z;
        const int step = NS ? NS : G;
        for (int it = c; it < NSM; it += step) {
            int r = it;
            if (r < I_GT) {
                const int q = r * 512 + tid, hp = q >> 14, n = (q >> 6) & 255, k0 = (q & 63) * 8;
                const int tap = k0 >> 7, cc0 = k0 & 127, co = hp * 128 + (n & 127), ho = co >> 6; const float* Wg = (n >> 7) ? p->in[19] : p->in[17];
                f32x4 a = (f32x4){0.f, 0.f, 0.f, 0.f}, b = a;
                if (((hp * 128 + cc0) >> 6) == ho) {
#pragma unroll
                    for (int x = 0; x < 8; ++x) { const int ci = hp * 128 + cc0 + x; const float v = p->in[15][tap * 512 + ci] * Wg[(ho * 64 + (ci & 63)) * 64 + (co & 63)]; if (x < 4) a[x] = v; else b[x - 4] = v; } }
                *(u32x4*)((bf16_t*)(ws + WS_GATES) + ((size_t)(hp * 256 + n) * 512 + k0)) = pack8(a, b);
                continue;
            } r -= I_GT;
            if (r < I_GB) { const int q = r * 512 + tid, hp = q >> 8, n = q & 255, co = hp * 128 + (n & 127), ho = co >> 6; const float* Wg = (n >> 7) ? p->in[19] : p->in[17];
                float s = ((n >> 7) ? p->in[20] : p->in[18])[co];
#pragma unroll 8
                for (int i = 0; i < 64; ++i) s += p->in[16][ho * 64 + i] * Wg[(ho * 64 + i) * 64 + (co & 63)];
                ((float*)(ws + WS_GBIAS))[q] = s; continue; } r -= I_GB;
            if (r < I_SP) { ((float*)(ws + WS_SP8))[tid] = 8.0f * log1pf(expf(-p->in[21][tid])); continue; } r -= I_SP;
            if (r < 112) *(u32x4*)(ws + WS_ZERO_BEG + ((size_t)r * 512 + tid) * 16) = (u32x4){0u, 0u, 0u, 0u};
            else { const int q = (r - 112) * 512 + tid;
                const int b = q / 192, w = q % 192; *(u32x4*)(ws + WS_XL + ((size_t)b * XLROWS * 512) * 2 + (size_t)w * 16) = (u32x4){0u, 0u, 0u, 0u}; }
        }
        for (int g = c; g < NG; g += step) p0_s5_tables(p, g, lds, tid);
        if (NS) return;
    }
    const int V = (c - NS) * 8 + wave, NV = (G - NS) * 8;
    LAS float* scr = (LAS float*)(lds + wave * 16640);
    constexpr int T_IN = 16 * 24, T_GLU = 64, T_SQ = 256, T_F1 = 16 * 64, T_F2 = 64 * 16, I_TR = T_IN + T_GLU + 5 * T_SQ + T_F1 + T_F2;
    for (int it = V; it < I_TR; it += NV) {
        int r = it;
        if (r < T_IN) { p0_tile_wave(p->in[4], 1024, 1536, nullptr, nullptr, 0, nullptr, nullptr, nullptr, (bf16_t*)(ws + WS_WIN), r, scr, lane); continue; } r -= T_IN;
        if (r < T_SQ) { p0_tile_wave(p->in[30], 1024, 1024, nullptr, nullptr, 0, nullptr, nullptr, nullptr, (bf16_t*)(ws + WS_WK), r, scr, lane); continue; } r -= T_SQ;
        if (r < T_SQ) { p0_tile_wave(p->in[31], 1024, 1024, nullptr, nullptr, 0, nullptr, nullptr, nullptr, (bf16_t*)(ws + WS_WV), r, scr, lane); continue; } r -= T_SQ;
        if (r < T_GLU) { p0_tile_wave(p->in[13], 512, 512, nullptr, nullptr, 0, nullptr, nullptr, nullptr, (bf16_t*)(ws + WS_WGLU), r, scr, lane); continue; } r -= T_GLU;
        if (r < T_SQ) { p0_tile_wave(p->in[24], 1024, 1024, p->in[22], p->in[23], 512, nullptr, nullptr, nullptr, (bf16_t*)(ws + WS_WMIX), r, scr, lane); continue; } r -= T_SQ;
        if (r < T_SQ) { p0_tile_wave(p->in[29], 1024, 1024, p->in[25], p->in[25], 1 << 30, p->in[26], (float*)(ws + WS_CPART), (float*)(ws + WS_CPART) + 16 * 1024, (bf16_t*)(ws + WS_WQ), r, scr, lane); continue; } r -= T_SQ;
        if (r < T_SQ) { p0_tile_wave(p->in[32], 1024, 1024, nullptr, nullptr, 0, nullptr, nullptr, nullptr, (bf16_t*)(ws + WS_WO), r, scr, lane); continue; } r -= T_SQ;
        if (r < T_F1) { p0_tile_wave(p->in[35], 1024, 4096, p->in[33], p->in[33], 1 << 30, p->in[34], (float*)(ws + WS_CPART) + 32 * 1024, (float*)(ws + WS_CPART) + 32 * 1024 + 16 * 4096, (bf16_t*)(ws + WS_WF1), r, scr, lane); continue; } r -= T_F1;
        p0_tile_wave(p->in[36], 4096, 1024, nullptr, nullptr, 0, nullptr, nullptr, nullptr, (bf16_t*)(ws + WS_WF2), r, scr, lane);
    }
    p0_ln_rows(p, ws, V, NV, lane);
}
__device__ __forceinline__ void p3_colsum_reduce(KP p, int c) {
    const int col = (c - 64) * NTHREADS + threadIdx.x; if (c < 64 || col >= 5120) return;
    const float* cp = (const float*)(p->ws + WS_CPART); float a = 0.f, b = 0.f;
    if (col < 1024) {
#pragma unroll
        for (int t = 0; t < 16; ++t) { a += cp[t * 1024 + col]; b += cp[16 * 1024 + t * 1024 + col]; }
        ((float*)(p->ws + WS_C1Q))[col] = a; ((float*)(p->ws + WS_C2Q))[col] = b;
    } else { const int cc = col - 1024; const float* cq = cp + 32 * 1024;
#pragma unroll
        for (int t = 0; t < 16; ++t) { a += cq[t * 4096 + cc]; b += cq[16 * 4096 + t * 4096 + cc]; }
        ((float*)(p->ws + WS_C1F))[cc] = a; ((float*)(p->ws + WS_C2F))[cc] = b; }
}
__device__ __forceinline__ void p3_s5_scan(KP p, int c) {
    const int gt = c * NTHREADS + threadIdx.x; if (gt >= NG * B * 64) return;
    const int g = gt >> 10, b = (gt >> 6) & 15, pp = gt & 63;
    const float lr = ((const float*)(p->ws + WS_LAML))[g * 128 + pp * 2], li = ((const float*)(p->ws + WS_LAML))[g * 128 + pp * 2 + 1];
    const float* xe = (const float*)(p->ws + WS_XEND) + ((size_t)(g * 1024 + b * NCH)) * 128 + 2 * pp;
    bf16_t* uo = (bf16_t*)(p->ws + WS_U) + ((size_t)(g * 1024 + b * NCH)) * 640 + 512 + 2 * pp;
    float xr = 0.f, xi = 0.f;
    for (int c0 = 0; c0 < NCH; c0 += 8) {
        f32x2 e[8];
#pragma unroll
        for (int j = 0; j < 8; ++j) e[j] = *(const f32x2*)(xe + (size_t)(c0 + j) * 128);
#pragma unroll
        for (int j = 0; j < 8; ++j) { *(unsigned*)(uo + (size_t)(c0 + j) * 640) = cvt_pk_bf16(xr, xi);
            const float nr = lr * xr - li * xi + e[j].x, ni = lr * xi + li * xr + e[j].y; xr = nr; xi = ni; }
    }
}
__device__ __forceinline__ void p3_lru_pass1(KP p, int G, int c) {
    const int ch = threadIdx.x; const float* LA = (const float*)(p->ws + WS_LA); const float* LB = (const float*)(p->ws + WS_LB); float* agg = (float*)(p->ws + WS_AGG);
    for (int it = c; it < B * NCH; it += G) {
        const size_t base = (size_t)it * CH * 512 + ch; float A = 1.f, h = 0.f;
#pragma unroll 8
        for (int t = 0; t < CH; ++t) { const float a = LA[base + (size_t)t * 512], bb = LB[base + (size_t)t * 512]; h = a * h + bb; A *= a; }
        agg[((size_t)it * 2) * 512 + ch] = A; agg[((size_t)it * 2 + 1) * 512 + ch] = h;
    }
}
__device__ __forceinline__ void p4_lru_pass2(KP p, LAS unsigned char* lds, int G, int c) {
    const int ch = threadIdx.x, lane = ch & 63, wave = ch >> 6; LAS float* yb = (LAS float*)lds;
    const float* LA = (const float*)(p->ws + WS_LA); const float* LB = (const float*)(p->ws + WS_LB); const float* agg = (const float*)(p->ws + WS_AGG);
    const bf16_t* GG = (const bf16_t*)(p->ws + WS_GG); bf16_t* YC = (bf16_t*)(p->ws + WS_YCAT);
    for (int it = c; it < B * NCH; it += G) {
        const int b = it >> 6, chunk = it & 63; float h = 0.f;
        for (int cc = 0; cc < chunk; ++cc) { const size_t a0 = ((size_t)(b * NCH + cc) * 2) * 512 + ch; h = agg[a0] * h + agg[a0 + 512]; }
        const size_t base = (size_t)it * CH * 512 + ch;
#pragma unroll 8
        for (int t = 0; t < CH; ++t) { const float a = LA[base + (size_t)t * 512], bb = LB[base + (size_t)t * 512]; h = a * h + bb; yb[t * 512 + ch] = h * bf2f(GG[base + (size_t)t * 512]); }
        __syncthreads();
#pragma unroll
        for (int q = 0; q < 4; ++q) { const int t = wave + 8 * q; const f32x4 v0 = *(LAS f32x4*)(yb + t * 512 + lane * 8), v1 = *(LAS f32x4*)(yb + t * 512 + lane * 8 + 4);
            float s = (v0[0] * v0[0] + v0[1] * v0[1]) + (v0[2] * v0[2] + v0[3] * v0[3]) + (v1[0] * v1[0] + v1[1] * v1[1]) + (v1[2] * v1[2] + v1[3] * v1[3]);
            const float rs = rsqrtf(wave_sum(s) * (1.0f / 512.0f) + 1e-6f);
            *(u32x4*)(YC + ((size_t)it * CH + t) * 1024 + 512 + lane * 8) = pack8(v0 * rs, v1 * rs); }
        __syncthreads();
    }
}
__device__ __forceinline__ void p13_final_ln(KP p, int G, int c) {
    const int lane = threadIdx.x & 63, wave = threadIdx.x >> 6; const float* st3 = (const float*)(p->ws + WS_STATS3);
    for (int row = c * 8 + wave; row < M; row += G * 8) {
        const f32x2 st = *(const f32x2*)(st3 + 2 * (size_t)row); const float mu = st.x * (1.0f / 1024.0f), rstd = rsqrtf(st.y * (1.0f / 1024.0f) - mu * mu + 1e-5f);
        float* o = p->out + (size_t)row * 1024;
#pragma unroll
        for (int j = 0; j < 4; ++j) { const f32x4 v = *(const f32x4*)(o + j * 256 + lane * 4), gg = *(const f32x4*)(p->in[37] + j * 256 + lane * 4), bb = *(const f32x4*)(p->in[38] + j * 256 + lane * 4);
            *(f32x4*)(o + j * 256 + lane * 4) = (v - mu) * rstd * gg + bb; }
    }
}

constexpr int NPHASES = 14;
#ifndef PH_MASK
#define PH_MASK 0x3fff
#endif
__global__ void __launch_bounds__(NTHREADS, 2) mega(Params p_unused) {
    extern __shared__ __attribute__((aligned(16))) unsigned char lds_raw[];
    LAS unsigned char* lds = (LAS unsigned char*)lds_raw;
    const int G = gridDim.x, c = blockIdx.x;
    unsigned char* ws; int lo, hi; { KP p = kargs(); ws = p->ws; lo = p->ph_lo; hi = p->ph_hi; }
#ifndef MK_CGSYNCS
#define MK_CGSYNCS 1
#endif
    volatile LAS unsigned* bst = (volatile LAS unsigned*)(lds + LDS_BARW);
    if (threadIdx.x < 4) bst[threadIdx.x] = 0u;
    __syncthreads();
    XcdBarrier xbar; xbar.bar = (unsigned*)ws; xbar.x = 0; xbar.st = bst;
    if (hi - lo > 1) xbar = xcd_barrier_post((unsigned*)ws, bst);
#define PH_END(k) if ((k) + 1 < hi) { if ((k) - lo < MK_CGSYNCS) cg::this_grid().sync(); else xcd_barrier(xbar); } else __syncthreads();
#if (PH_MASK >> 0) & 1
        if (lo <= 0 && 0 < hi) { KP p = kargs(); p0_prep(p, lds, G, c); PH_END(0) }
#endif
#if (PH_MASK >> 1) & 1
        if (lo <= 1 && 1 < hi) { KP p = kargs(); {
            { PlainGeom<1024, 1024, M, DIN, 1024> g; g.A = (const bf16_t*)(ws + WS_H0B); g.Bt = (const bf16_t*)(ws + WS_WIN);
              EpiZ E; E.U = (bf16_t*)(ws + WS_U); E.XL = (bf16_t*)(ws + WS_XL); E.GG = (bf16_t*)(ws + WS_GG); gemm_phase(lds, g, E, G, c); }
            { PlainGeom<1024, 1024, 4096, 1024, 1024> g; g.A = (const bf16_t*)(ws + WS_MEMN); g.Bt = (const bf16_t*)(ws + WS_WK);
              EpiBf16 E; E.O = (bf16_t*)(ws + WS_KMAT); E.ldc = 1024; E.bdiv = 1; E.ob0 = 0; E.ob1 = 0; gemm_phase(lds, g, E, G, c); }
            { PlainGeom<1024, 1024, 1024, 4096, 1024> g; g.A = (const bf16_t*)(ws + WS_WV); g.Bt = (const bf16_t*)(ws + WS_MEMN);
              EpiBf16 E; E.O = (bf16_t*)(ws + WS_VT); E.ldc = 4096; E.bdiv = 1; E.ob0 = 0; E.ob1 = 0; gemm_phase(lds, g, E, G, (c + G - 64) % G); }
        } PH_END(1) }
#endif
#if (PH_MASK >> 2) & 1
        if (lo <= 2 && 2 < hi) { KP p = kargs(); {
            { GeomT<640, 512, 8, 4, 1, NG, 256L * 640, 1024L * 640, 0, 1, 0, 256L * 512, 0, 0> g; g.A = (const bf16_t*)(ws + WS_U); g.Bt = (const bf16_t*)(ws + WS_S5P);
              EpiXend E; E.X = (float*)(ws + WS_XEND); gemm_phase(lds, g, E, G, c); }
            { GeomT<512, 512, 8, 8, 1, 64, 256L * 512, 128, (long)XLROWS * 512, 16, 0, 256L * 512, 0, 1> g; g.A = (const bf16_t*)(ws + WS_XL); g.Bt = (const bf16_t*)(ws + WS_GATES);
              EpiGates E; E.XL = (const bf16_t*)(ws + WS_XL); E.cw = p->in[15]; E.cb = p->in[16]; E.gbias = (const float*)(ws + WS_GBIAS); E.sp8 = (const float*)(ws + WS_SP8);
              E.LA = (float*)(ws + WS_LA); E.LB = (float*)(ws + WS_LB); gemm_phase(lds, g, E, G, (c + G - 128) % G); }
        } PH_END(2) }
#endif
#if (PH_MASK >> 3) & 1
        if (lo <= 3 && 3 < hi) { KP p = kargs(); p3_s5_scan(p, c); p3_colsum_reduce(p, c); p3_lru_pass1(p, G, G - 1 - c); PH_END(3) }
#endif
#if (PH_MASK >> 4) & 1
        if (lo <= 4 && 4 < hi) { KP p = kargs(); {
            { GeomT<640, 640, 10, 4, 2, NG, 256L * 640, 1024L * 640, 0, 1, 256L * 640, 512L * 640, 0, 0> g; g.A = (const bf16_t*)(ws + WS_U); g.Bt = (const bf16_t*)(ws + WS_S5T);
              EpiS5 E; E.U = (const bf16_t*)(ws + WS_U); E.dd = p->in[12]; E.Y1 = (bf16_t*)(ws + WS_Y1); gemm_phase(lds, g, E, G, c); }
            p4_lru_pass2(p, lds, G, c);
        } PH_END(4) }
#endif
#if (PH_MASK >> 5) & 1
        if (lo <= 5 && 5 < hi) { KP p = kargs(); { PlainGeom<512, 512, M, 512, 512> g; g.A = (const bf16_t*)(ws + WS_Y1); g.Bt = (const bf16_t*)(ws + WS_WGLU);
            EpiGlu E; E.Y1 = (const bf16_t*)(ws + WS_Y1); E.bg = p->in[14]; E.YC = (bf16_t*)(ws + WS_YCAT); E.ssq = (float*)(ws + WS_SSQ); gemm_phase(lds, g, E, G, c); } PH_END(5) }
#endif
#if (PH_MASK >> 6) & 1
        if (lo <= 6 && 6 < hi) { KP p = kargs(); { PlainGeom<1024, 1024, M, 1024, 1024> g; g.A = (const bf16_t*)(ws + WS_YCAT); g.Bt = (const bf16_t*)(ws + WS_WMIX);
            EpiRes<0, true, 8> E; E.prev = p->in[0]; E.pstats = (const float*)(ws + WS_STATS0); E.pg = p->in[2]; E.pb_ = p->in[3]; E.vout = (float*)(ws + WS_V1); E.vb = (bf16_t*)(ws + WS_V1B);
            E.ostats = (float*)(ws + WS_STATS1); E.ssq = (const float*)(ws + WS_SSQ); gemm_phase(lds, g, E, G, c); } PH_END(6) }
#endif
#if (PH_MASK >> 7) & 1
        if (lo <= 7 && 7 < hi) { KP p = kargs(); { PlainGeom<1024, 1024, M, 1024, 1024> g; g.A = (const bf16_t*)(ws + WS_V1B); g.Bt = (const bf16_t*)(ws + WS_WQ);
            EpiFold<0> E; E.pstats = (const float*)(ws + WS_STATS1); E.c1 = (const float*)(ws + WS_C1Q); E.c2 = (const float*)(ws + WS_C2Q); E.O = (bf16_t*)(ws + WS_Q); E.ldc = 1024; E.sc = 0.0625f;
            gemm_phase(lds, g, E, G, c); } PH_END(7) }
#endif
#if (PH_MASK >> 8) & 1
        if (lo <= 8 && 8 < hi) { KP p = kargs(); { GeomT<1024, 1024, 4, 8, 1, 64, 256L * 1024, 2048L * 1024, 256, 4, 0, 256L * 1024, 256, 0> g; g.A = (const bf16_t*)(ws + WS_Q); g.Bt = (const bf16_t*)(ws + WS_KMAT);
            EpiSoftmax E; E.P = (bf16_t*)(ws + WS_PROB); gemm_phase(lds, g, E, G, c); } PH_END(8) }
#endif
#if (PH_MASK >> 9) & 1
        if (lo <= 9 && 9 < hi) { KP p = kargs(); { GeomT<256, 4096, 4, 8, 1, 64, 256L * 256, 4L * 2048 * 256, 2048L * 256, 4, 0, 256, 256L * 4096, 0> g; g.A = (const bf16_t*)(ws + WS_PROB); g.Bt = (const bf16_t*)(ws + WS_VT);
            EpiBf16 E; E.O = (bf16_t*)(ws + WS_AO); E.ldc = 1024; E.bdiv = 4; E.ob0 = 2048L * 1024; E.ob1 = 256; gemm_phase(lds, g, E, G, c); } PH_END(9) }
#endif
#if (PH_MASK >> 10) & 1
        if (lo <= 10 && 10 < hi) { KP p = kargs(); { PlainGeom<1024, 1024, M, 1024, 1024> g; g.A = (const bf16_t*)(ws + WS_AO); g.Bt = (const bf16_t*)(ws + WS_WO);
            EpiRes<1, true, -1> E; E.prev = (const float*)(ws + WS_V1); E.pstats = (const float*)(ws + WS_STATS1); E.pg = p->in[25]; E.pb_ = p->in[26]; E.vout = (float*)(ws + WS_V2); E.vb = (bf16_t*)(ws + WS_V1B);
            E.ostats = (float*)(ws + WS_STATS2); E.ssq = nullptr; gemm_phase(lds, g, E, G, c); } PH_END(10) }
#endif
#if (PH_MASK >> 11) & 1
        if (lo <= 11 && 11 < hi) { KP p = kargs(); { PlainGeom<1024, 1024, M, DFF, 1024> g; g.A = (const bf16_t*)(ws + WS_V1B); g.Bt = (const bf16_t*)(ws + WS_WF1);
            EpiFold<1> E; E.pstats = (const float*)(ws + WS_STATS2); E.c1 = (const float*)(ws + WS_C1F); E.c2 = (const float*)(ws + WS_C2F); E.O = (bf16_t*)(ws + WS_HDN); E.ldc = DFF; E.sc = 1.f;
            gemm_phase(lds, g, E, G, c); } PH_END(11) }
#endif
#if (PH_MASK >> 12) & 1
        if (lo <= 12 && 12 < hi) { KP p = kargs(); { PlainGeom<DFF, DFF, M, 1024, DFF> g; g.A = (const bf16_t*)(ws + WS_HDN); g.Bt = (const bf16_t*)(ws + WS_WF2);
            EpiRes<1, false, -1> E; E.prev = (const float*)(ws + WS_V2); E.pstats = (const float*)(ws + WS_STATS2); E.pg = p->in[33]; E.pb_ = p->in[34]; E.vout = p->out; E.vb = nullptr;
            E.ostats = (float*)(ws + WS_STATS3); E.ssq = nullptr; gemm_phase(lds, g, E, G, c); } PH_END(12) }
#endif
#if (PH_MASK >> 13) & 1
        if (lo <= 13 && 13 < hi) { KP p = kargs(); p13_final_ln(p, G, c); PH_END(13) }
#endif
#undef PH_END
}
}
#ifndef MK_MULTI
#define MK_MULTI 0
#endif
#ifndef MK_DEBUG
#define MK_DEBUG 0
#endif
#if MK_DEBUG
namespace dbg {
using namespace fp;
__device__ __forceinline__ float gelu_ref(float x) { const float k = 0.7978845608028654f; float u = k * (x + 0.044715f * x * x * x); return 0.5f * x * (1.0f + tanhf(u)); }
struct CmpArgs { const unsigned char* ws; const float* ref; const float* aux0; const float* aux1; int mode, rows, cols, ldr, bd; float* acc; };
__global__ void __launch_bounds__(256) k_cmp(CmpArgs a) {
    __shared__ float red[8];
    float d2 = 0.f, r2 = 0.f; const size_t n = (size_t)a.rows * a.cols;
    for (size_t i = (size_t)blockIdx.x * 256 + threadIdx.x; i < n; i += (size_t)gridDim.x * 256) {
        const int t = (int)(i / a.cols), c = (int)(i % a.cols); const size_t row = (size_t)a.bd * S + t;
        float f = 0.f, r = a.ref[(size_t)t * a.ldr + c];
        switch (a.mode) {
        case 1: { const int g = c >> 4, hi = c & 15; f = bf2f(((const bf16_t*)(a.ws + WS_U))[((size_t)(g * 1024 + a.bd * NCH + (t >> 5))) * 640 + (t & 31) * 16 + hi]); } break;
        case 2: f = bf2f(((const bf16_t*)(a.ws + WS_XL))[((size_t)(a.bd * XLROWS + 3 + t)) * 512 + c]); break;
        case 3: f = bf2f(((const bf16_t*)(a.ws + WS_GG))[row * 512 + c]); r = gelu_ref(r); break;
        case 4: f = bf2f(((const bf16_t*)(a.ws + WS_KMAT))[((size_t)(a.bd * 256 + t)) * 1024 + c]); break;
        case 5: f = bf2f(((const bf16_t*)(a.ws + WS_VT))[(size_t)c * 4096 + a.bd * 256 + t]); break;
        case 6: f = 1.0f - ((const float*)(a.ws + WS_LA))[row * 512 + c]; r = 1.0f - r; break;
        case 7: f = ((const float*)(a.ws + WS_LB))[row * 512 + c]; break;
        case 8: f = bf2f(((const bf16_t*)(a.ws + WS_Y1))[row * 512 + c]); break;
        case 9: f = bf2f(((const bf16_t*)(a.ws + WS_YCAT))[row * 1024 + 512 + c]) * a.aux0[c]; break;
        case 10: f = bf2f(((const bf16_t*)(a.ws + WS_YCAT))[row * 1024 + c]) * rsqrtf(((const float*)(a.ws + WS_SSQ))[row] * (1.0f / 512.0f) + 1e-6f) * a.aux0[c]; break;
        case 11: { const float* st = (const float*)(a.ws + WS_STATS1) + 2 * row; const float mu = st[0] * (1.0f / 1024.0f), rs = rsqrtf(st[1] * (1.0f / 1024.0f) - mu * mu + 1e-5f);
            f = (((const float*)(a.ws + WS_V1))[row * 1024 + c] - mu) * rs * a.aux0[c] + a.aux1[c]; } break;
        case 12: f = 16.0f * bf2f(((const bf16_t*)(a.ws + WS_Q))[row * 1024 + c]); break;
        case 13: f = bf2f(((const bf16_t*)(a.ws + WS_AO))[row * 1024 + c]); break;
        case 14: { const float* st = (const float*)(a.ws + WS_STATS2) + 2 * row; const float mu = st[0] * (1.0f / 1024.0f), rs = rsqrtf(st[1] * (1.0f / 1024.0f) - mu * mu + 1e-5f);
            f = (((const float*)(a.ws + WS_V2))[row * 1024 + c] - mu) * rs * a.aux0[c] + a.aux1[c]; } break;
        case 15: f = bf2f(((const bf16_t*)(a.ws + WS_HDN))[row * 4096 + c]); break;
        default: break;
        }
        const float d = f - r; d2 += d * d; r2 += r * r;
    }
    for (int o = 32; o > 0; o >>= 1) { d2 += __shfl_xor(d2, o); r2 += __shfl_xor(r2, o); }
    if ((threadIdx.x & 63) == 0) { red[(threadIdx.x >> 6) * 2] = d2; red[(threadIdx.x >> 6) * 2 + 1] = r2; }
    __syncthreads();
    if (threadIdx.x == 0) { atomicAdd(a.acc + a.mode * 2, red[0] + red[2] + red[4] + red[6]); atomicAdd(a.acc + a.mode * 2 + 1, red[1] + red[3] + red[5] + red[7]); }
}
__global__ void k_final(const float* acc, float* out, float tol) {
    if (threadIdx.x != 0 || blockIdx.x != 0) return;
    for (int m = 1; m <= 15; ++m) { const float d = acc[m * 2], r = acc[m * 2 + 1]; const float e = sqrtf(d / fmaxf(r, 1e-30f));
        if (!(e <= tol)) { float k = 1e4f; if (!(e < 0.1f)) k = 1e5f; if (!(e < 1.0f)) k = 1e6f; out[0] = (10.0f + m) * k; return; } }
}
}
#endif

extern "C" void kernel_launch(void* const* d_in, const int* in_sizes, int n_in, void* d_out, int out_size, void* d_ws, size_t ws_size, hipStream_t stream) {
    (void)in_sizes; (void)n_in; (void)out_size;
    static int grid = 0;
    if (grid == 0) {
        int dev = 0, cus = 0, per_cu = 0;
        hipGetDevice(&dev); hipDeviceGetAttribute(&cus, hipDeviceAttributeMultiprocessorCount, dev);
        hipFuncSetAttribute((const void*)fp::mega, hipFuncAttributeMaxDynamicSharedMemorySize, fp::LDS_BYTES);
        hipOccupancyMaxActiveBlocksPerMultiprocessor(&per_cu, (const void*)fp::mega, fp::NTHREADS, fp::LDS_BYTES);
        if (per_cu < 1) { fprintf(stderr, "kernel_launch: occupancy query says %d blocks/CU\n", per_cu); per_cu = 1; }
        grid = cus * 1;
        if (ws_size < fp::WS_END) fprintf(stderr, "kernel_launch: workspace too small: %zu < %zu\n", ws_size, (size_t)fp::WS_END);
        (void)hipGetLastError();
    }
    fp::Params p{};
    for (int i = 0; i < 39; ++i) p.in[i] = (const float*)d_in[i];
    p.out = (float*)d_out; p.ws = (unsigned char*)d_ws;
#if MK_DEBUG
    const int bd = 5;
    float* nws = (float*)d_out;
    float* f1x = nws + nv::naive_floats(1);
    float* acc = (float*)((unsigned char*)d_ws + fp::WS_DBG);
    hipMemsetAsync(acc, 0, 256, stream);
    nv::NaiveBufs NB = nv::run_naive(d_in, nullptr, nws, stream, bd, 1, 9, f1x);
    const float* z = NB.big; const float* xc = z + (size_t)nv::S * 1536; const float* pa = xc + (size_t)nv::S * 512; const float* px = pa + (size_t)nv::S * 512;
    const float* ylru = px + (size_t)nv::S * 512; const float* ys = ylru + (size_t)nv::S * 512; (void)ylru;
    auto cmp = [&](int mode, const float* ref, int rows, int cols, int ldr, const float* a0, const float* a1) {
        dbg::CmpArgs a{(const unsigned char*)d_ws, ref, a0, a1, mode, rows, cols, ldr, bd, acc};
        hipLaunchKernelGGL(dbg::k_cmp, dim3(512), dim3(256), 0, stream, a); };
    auto phase = [&](int ph) { p.ph_lo = ph; p.ph_hi = ph + 1; hipLaunchKernelGGL(fp::mega, dim3(grid), dim3(fp::NTHREADS), fp::LDS_BYTES, stream, p); };
    auto fin = (const float* const*)d_in;
    phase(0); phase(1);
    cmp(1, z, 2048, 512, 1536, nullptr, nullptr); cmp(2, z + 512, 2048, 512, 1536, nullptr, nullptr); cmp(3, z + 1024, 2048, 512, 1536, nullptr, nullptr);
    cmp(4, NB.Km, 256, 1024, 1024, nullptr, nullptr); cmp(5, NB.Vm, 256, 1024, 1024, nullptr, nullptr);
    phase(2);
    cmp(6, pa, 2048, 512, 512, nullptr, nullptr); cmp(7, px, 2048, 512, 512, nullptr, nullptr);
    phase(3); phase(4);
    cmp(8, ys, 2048, 512, 512, nullptr, nullptr); cmp(9, NB.ycat + 512, 2048, 512, 1024, fin[23], nullptr);
    phase(5);
    cmp(10, NB.ycat, 2048, 512, 1024, fin[22], nullptr);
    phase(6);
    cmp(11, NB.h1, 2048, 1024, 1024, fin[25], fin[26]);
    phase(7);
    cmp(12, NB.q, 2048, 1024, 1024, nullptr, nullptr);
    phase(8); phase(9);
    cmp(13, NB.ao, 2048, 1024, 1024, nullptr, nullptr);
    phase(10);
    cmp(14, NB.h2, 2048, 1024, 1024, fin[33], fin[34]);
    phase(11);
    cmp(15, f1x, 2048, 4096, 4096, nullptr, nullptr);
    phase(12); phase(13);
    hipLaunchKernelGGL(dbg::k_final, dim3(1), dim3(64), 0, stream, (const float*)acc, (float*)d_out, 0.03f);
#elif MK_MULTI
    for (int ph = 0; ph < fp::NPHASES; ++ph) { p.ph_lo = ph; p.ph_hi = ph + 1; hipLaunchKernelGGL(fp::mega, dim3(grid), dim3(fp::NTHREADS), fp::LDS_BYTES, stream, p); }
#else
    p.ph_lo = 0; p.ph_hi = fp::NPHASES;
    (void)hipMemsetAsync(d_ws, 0, 16384, stream);
    void* args[] = {&p};
    hipError_t e = hipLaunchCooperativeKernel((const void*)fp::mega, dim3(grid), dim3(fp::NTHREADS), args, fp::LDS_BYTES, stream);
    if (e != hipSuccess) fprintf(stderr, "cooperative launch failed: %s (grid %d)\n", hipGetErrorString(e), grid);
#endif
}
```

```cpp
#include <hip/hip_runtime.h>
#include <cstdio>
#define MK_MULTI 0
#define MK_DEBUG 0
#include <hip/hip_cooperative_groups.h>
namespace cg = cooperative_groups;
namespace fp {
#define LAS __attribute__((address_space(3)))
typedef unsigned short bf16_t;
typedef short bf16x8 __attribute__((ext_vector_type(8)));
typedef float f32x4 __attribute__((ext_vector_type(4)));
typedef float f32x2 __attribute__((ext_vector_type(2)));
typedef unsigned u32x4 __attribute__((ext_vector_type(4)));
typedef unsigned u32x2 __attribute__((ext_vector_type(2)));

constexpr int D = 1024, S = 2048, B = 16, M = B * S, DIN = 1536, DFF = 4096, MEM = 256, NG = 32, CH = 32  , NCH = S / CH  ;
constexpr float ALPHA = 1.189207115002721f;
constexpr int NTHREADS = 512;

constexpr size_t MiB = 1u << 20, KiB = 1u << 10;
constexpr size_t WS_STATS0 = 64 * KiB;
constexpr size_t WS_SSQ = 320 * KiB;
constexpr size_t WS_STATS1 = 448 * KiB;
constexpr size_t WS_STATS2 = 704 * KiB;
constexpr size_t WS_STATS3 = 960 * KiB;
constexpr size_t WS_ZERO_BEG = WS_SSQ, WS_ZERO_END = 1216 * KiB;
constexpr size_t WS_C1Q = 1216 * KiB, WS_C2Q = WS_C1Q + 4096, WS_C1F = WS_C2Q + 4096, WS_C2F = WS_C1F + 16384;
constexpr size_t WS_GBIAS = 1256 * KiB;
constexpr size_t WS_SP8 = 1260 * KiB;
constexpr size_t WS_LAML = 1264 * KiB;
constexpr size_t WS_DBG = 1300 * KiB;
constexpr size_t WS_CPART = 2 * MiB;
constexpr size_t WS_WIN = 4 * MiB;
constexpr size_t WS_WGLU = 7 * MiB;
constexpr size_t WS_WMIX = WS_WGLU + MiB / 2;
constexpr size_t WS_WQ = WS_WMIX + 2 * MiB, WS_WK = WS_WQ + 2 * MiB, WS_WV = WS_WK + 2 * MiB, WS_WO = WS_WV + 2 * MiB;
constexpr size_t WS_WF1 = WS_WO + 2 * MiB;
constexpr size_t WS_WF2 = WS_WF1 + 8 * MiB;
constexpr size_t WS_S5T = 34 * MiB + MiB / 2;
constexpr size_t WS_S5P = WS_S5T + 20 * MiB;
constexpr size_t WS_GATES = WS_S5P + 8 * MiB;
constexpr size_t WS_V1B = 64 * MiB;
constexpr size_t WS_YCAT = 128 * MiB;
constexpr size_t WS_PROB = 128 * MiB;
constexpr size_t WS_V2 = 128 * MiB;
constexpr size_t WS_KMAT = 192 * MiB;
constexpr size_t WS_VT = 200 * MiB;
constexpr size_t WS_Y1 = 208 * MiB;
constexpr size_t WS_U = 256 * MiB;
constexpr size_t WS_XL = 296 * MiB;
constexpr size_t WS_GG = 330 * MiB;
constexpr size_t WS_XEND = 362 * MiB;
constexpr size_t WS_AGG = 378 * MiB;
constexpr size_t WS_V1 = 256 * MiB;
constexpr size_t WS_H0B = 384 * MiB;
constexpr size_t WS_LA = 384 * MiB;
constexpr size_t WS_AO = 384 * MiB;
constexpr size_t WS_MEMN = 448 * MiB;
constexpr size_t WS_LB = 448 * MiB;
constexpr size_t WS_Q = 448 * MiB;
constexpr size_t WS_HDN = 256 * MiB;
constexpr size_t WS_END = 512 * MiB;
constexpr int XLROWS = S + 3;

constexpr int LDS_STAGE = 131072, LDS_X = LDS_STAGE  , LDS_BARW = LDS_STAGE + 8192  , LDS_BYTES = 147456;

__device__ __forceinline__ unsigned cvt_pk_bf16(float lo, float hi) { unsigned r; asm volatile("v_cvt_pk_bf16_f32 %0, %1, %2" : "=v"(r) : "v"(lo), "v"(hi)); return r; }
__device__ __forceinline__ bf16_t f2bf(float f) { return (bf16_t)(cvt_pk_bf16(f, 0.f) & 0xffffu); }
__device__ __forceinline__ float bf2f(unsigned short b) { return __uint_as_float(((unsigned)b) << 16); }
__device__ __forceinline__ float bflo(unsigned w) { return __uint_as_float(w << 16); }
__device__ __forceinline__ float bfhi(unsigned w) { return __uint_as_float(w & 0xffff0000u); }
__device__ __forceinline__ u32x4 pack8(f32x4 a, f32x4 b) { u32x4 w; w.x = cvt_pk_bf16(a[0], a[1]); w.y = cvt_pk_bf16(a[2], a[3]); w.z = cvt_pk_bf16(b[0], b[1]); w.w = cvt_pk_bf16(b[2], b[3]); return w; }
__device__ __forceinline__ void unpack8(u32x4 w, f32x4& a, f32x4& b) { a[0] = bflo(w.x); a[1] = bfhi(w.x); a[2] = bflo(w.y); a[3] = bfhi(w.y); b[0] = bflo(w.z); b[1] = bfhi(w.z); b[2] = bflo(w.w); b[3] = bfhi(w.w); }
__device__ __forceinline__ float fast_exp(float x) { return __builtin_amdgcn_exp2f(x * 1.4426950408889634f); }
__device__ __forceinline__ float fast_rcp(float x) { return __builtin_amdgcn_rcpf(x); }
__device__ __forceinline__ float sigm(float x) { return fast_rcp(1.0f + fast_exp(-x)); }
__device__ __forceinline__ float gelu_t(float x) {
    const float u = 0.7978845608028654f * (x + 0.044715f * x * x * x);
    return x * sigm(2.0f * u);
}
__device__ __forceinline__ int lane_id() { return (int)__builtin_amdgcn_mbcnt_hi(~0u, __builtin_amdgcn_mbcnt_lo(~0u, 0u)); }
#define TID(wv) ((wv) * 64 + lane_id())
__device__ __forceinline__ float wave_sum(float v) {
#pragma unroll
    for (int o = 32; o > 0; o >>= 1) v += __shfl_xor(v, o);
    return v;
}


#define XB_TMO      128
#define XB_XCNT(j)  (256  + 64 * (j))
#define XB_XSUB(j)  (1280 + 64 * (j))
#define XB_XGEN(j)  (2304 + 64 * (j))
#define XB_TOP      3328
#define XB_TOPGEN   3392
#define XCD_BAR_WORDS 3456
#define XB_SPIN_CAP (1u << 18)
__device__ __forceinline__ unsigned xb_ld(unsigned* p)              { return __hip_atomic_load(p, __ATOMIC_RELAXED, __HIP_MEMORY_SCOPE_AGENT); }
__device__ __forceinline__ unsigned xb_add(unsigned* p, unsigned v) { return __hip_atomic_fetch_add(p, v, __ATOMIC_RELAXED, __HIP_MEMORY_SCOPE_AGENT); }
__device__ __forceinline__ unsigned xb_xcc_id() { return (unsigned)__builtin_amdgcn_s_getreg((3 << 11) | 20) & 0xFu; }
#define XB_SPIN(cond, bar) do { unsigned _sp = 0; while (cond) { __builtin_amdgcn_s_sleep(1); \
    if ((++_sp & 255u) == 0u) { if (xb_ld(&(bar)[XB_TMO])) break; if (_sp > XB_SPIN_CAP) { atomicAdd(&(bar)[XB_TMO], 1u); break; } } } } while (0)
struct XcdBarrier { unsigned* bar; unsigned x; volatile LAS unsigned* st; };
__device__ __forceinline__ XcdBarrier xcd_barrier_post(unsigned* bar, volatile LAS unsigned* st, int wv) {
    XcdBarrier b; b.bar = bar; b.x = xb_xcc_id(); b.st = st;
    if (TID(wv) == 0) (void)xb_add(&bar[XB_XCNT(b.x)], 1u);
    return b;
}
__device__ __forceinline__ void xcd_barrier_complete(unsigned* bar, unsigned x, unsigned& nloc, unsigned& nx) {
    const unsigned G = gridDim.x * gridDim.y * gridDim.z;
    unsigned sum, cnt, mine, sp = 0u;
    for (;;) {
        sum = 0u; cnt = 0u; mine = 0u;
#pragma unroll
        for (unsigned j = 0; j < 16; ++j) { const unsigned c = xb_ld(&bar[XB_XCNT(j)]); sum += c; cnt += (c > 0u) ? 1u : 0u; mine = (j == x) ? c : mine; }
        if (sum == G) break;
        __builtin_amdgcn_s_sleep(1);
        if ((++sp & 255u) == 0u) { if (xb_ld(&bar[XB_TMO])) break; if (sp > XB_SPIN_CAP) { atomicAdd(&bar[XB_TMO], 1u); break; } }
    }
    nloc = mine > 0u ? mine : 1u; nx = cnt > 0u ? cnt : 1u;
}
__device__ __forceinline__ void xcd_barrier(const XcdBarrier& b, int wv) {
    asm volatile("s_waitcnt vmcnt(0)" ::: "memory");
    __syncthreads();
    if (TID(wv) == 0) {
        unsigned* bar = b.bar;
        __builtin_amdgcn_s_waitcnt(0);
        unsigned nloc = b.st[0], nx = b.st[1];
        if (nloc == 0u) { xcd_barrier_complete(bar, b.x, nloc, nx); b.st[0] = nloc; b.st[1] = nx; }
        const unsigned old = xb_add(&bar[XB_XSUB(b.x)], 1u);
        const unsigned gen = old / nloc;
        if (old + 1u == (gen + 1u) * nloc) {
            __builtin_amdgcn_fence(__ATOMIC_RELEASE, "agent");
            asm volatile("s_waitcnt vmcnt(0)" ::: "memory");
            const unsigned og = xb_add(&bar[XB_TOP], 1u);
            const unsigned tg = og / nx;
            if (og + 1u == (tg + 1u) * nx) xb_add(&bar[XB_TOPGEN], 1u);
            else XB_SPIN(xb_ld(&bar[XB_TOPGEN]) == tg, bar);
            __builtin_amdgcn_fence(__ATOMIC_ACQUIRE, "agent");
            xb_add(&bar[XB_XGEN(b.x)], 1u);
            asm volatile("s_waitcnt vmcnt(0)" ::: "memory");
        } else {
            XB_SPIN(xb_ld(&bar[XB_XGEN(b.x)]) == gen, bar);
            __builtin_amdgcn_fence(__ATOMIC_ACQUIRE, "agent");
            asm volatile("s_waitcnt vmcnt(0)" ::: "memory");
        }
    }
    __syncthreads();
}

constexpr int BM = 256, BK = 64, HALF = 128, HTB = HALF * BK * 2, NXCD = 8, WGM = 8;
__device__ __forceinline__ int lds_byte(int r, int c) { const int st = (r >> 4) * 2 + (c >> 5), rr = r & 15, cc = c & 31, ob = rr * 64 + cc * 2; return st * 1024 + (ob ^ (((ob >> 9) & 1) << 5)); }
__device__ __forceinline__ void stage_rc(int b, int& R, int& C) { const int st = b / 1024, sb = b % 1024, swz = sb ^ (((sb >> 9) & 1) << 5); R = (st >> 1) * 16 + swz / 64; C = (st & 1) * 32 + (swz % 64) / 2; }
__device__ __forceinline__ int perm32(int rho) { const int n = rho >> 4, i = rho & 15; return 8 * (i >> 2) + 4 * n + (i & 3); }

struct Unit { int pm, pn, pb; };
template <int LDA, int LDB, int NT, int NM, int NN, int NB, long SAM, long SAB0, long SAB1, int BDIV, long SBN, long SBB0, long SBB1, int CONV>
struct GeomT {
    const bf16_t* A; const bf16_t* Bt;
    static constexpr int lda = LDA, ldb = LDB, nt = NT;
    static constexpr int nwg = NM * NN * NB;
    __device__ __forceinline__ bool next(int i, int G, int c, Unit& u) const {
        const int L = i * G + c; if (L >= nwg) return false;
        int wgid = L; { constexpr int q = nwg / NXCD, r = nwg % NXCD; const int xcd = wgid % NXCD, off = wgid / NXCD; wgid = (xcd < r ? xcd * (q + 1) : r * (q + 1) + (xcd - r) * q) + off; }
        constexpr int per = NM * NN; u.pb = wgid / per; const int w = wgid % per;
        constexpr int nig = WGM * NN; const int gid = w / nig, fm = gid * WGM, gsz = (NM - fm) < WGM ? (NM - fm) : WGM;
        u.pm = fm + ((w % nig) % gsz); u.pn = (w % nig) / gsz; return true;
    }
    __device__ __forceinline__ const char* abase(const Unit& u) const { return (const char*)(A + (long)u.pm * SAM + (long)(u.pb / BDIV) * SAB0 + (long)(u.pb % BDIV) * SAB1); }
    __device__ __forceinline__ const char* bbase(const Unit& u) const { return (const char*)(Bt + (long)u.pn * SBN + (long)(u.pb / BDIV) * SBB0 + (long)(u.pb % BDIV) * SBB1); }
    static __device__ __forceinline__ size_t koffA(int t) { return CONV ? ((size_t)(t >> 1) * (size_t)LDA * 2 + (size_t)(t & 1) * 128) : (size_t)t * 128; }
    static __device__ __forceinline__ size_t koffB(int t) { return (size_t)t * 128; }
};
template <int LDA, int LDB, int Mr, int Nc, int K> using PlainGeom = GeomT<LDA, LDB, K / 64, Mr / 256, Nc / 256, 1, 256L * LDA, 0, 0, 1, 256L * LDB, 0, 0, 0>;

template <class Geom, class Epi>
__device__ __forceinline__ void gemm_phase(LAS unsigned char* lds, const Geom g, const Epi& E, const int G, const int c, const int wv) {
    int lane_ = lane_id(); asm volatile("" : "+v"(lane_));
    const int lane = lane_, wid = wv, tid = wv * 64 + lane, wr = wid >> 2, wc = wid & 3, fr = lane & 15, fq = lane >> 4;
    constexpr int nt = Geom::nt;
    unsigned voffA, voffB;
    { int R, C; stage_rc(tid * 16, R, C); const int Rb = (R & ~31) + perm32(R & 31); voffA = (unsigned)(R * Geom::lda + C) * 2u; voffB = (unsigned)(Rb * Geom::ldb + C) * 2u; }
    constexpr size_t pieceA = (size_t)64 * Geom::lda * 2, pieceB = (size_t)64 * Geom::ldb * 2;
    constexpr size_t hstepA = (size_t)HALF * Geom::lda * 2, hstepB = (size_t)HALF * Geom::ldb * 2;
    const unsigned ldsw = (unsigned)wid * 1024u;
    const int aoff = lds_byte(wr * 64 + fr, fq * 8), boff = lds_byte(wc * 32 + fr, fq * 8);
#define PG8_SA(b, h) (((b) * 2 + (h)) * HTB)
#define PG8_SB(b, h) ((4 + (b) * 2 + (h)) * HTB)
#define pievoffA pieceA
#define pievoffB pieceB
#define PG8_STAGE(bufoff, gbase, voff) do { _Pragma("unroll") for (int _i = 0; _i < 2; ++_i) \
        __builtin_amdgcn_global_load_lds((const unsigned*)((const char*)(gbase) + (size_t)_i * pie##voff + (voff)), (LAS unsigned*)(lds + (bufoff) + ldsw + _i * 8192), 16, 0, 0); } while (0)
#define PG8_LDA(dst, b, h) do { _Pragma("unroll") for (int m = 0; m < 4; ++m) _Pragma("unroll") for (int k = 0; k < 2; ++k) dst[m][k] = *(const LAS bf16x8*)(lds + PG8_SA(b, h) + aoff + m * 2048 + k * 1024); } while (0)
#define PG8_LDB(dst, b, h) do { _Pragma("unroll") for (int n = 0; n < 2; ++n) _Pragma("unroll") for (int k = 0; k < 2; ++k) dst[n][k] = *(const LAS bf16x8*)(lds + PG8_SB(b, h) + boff + n * 2048 + k * 1024); } while (0)
#define PG8_MMA(ai, bj, At, Bt) do { __builtin_amdgcn_s_setprio(1); _Pragma("unroll") for (int m = 0; m < 4; ++m) _Pragma("unroll") for (int n = 0; n < 2; ++n) _Pragma("unroll") for (int k = 0; k < 2; ++k) \
        acc[ai][bj][m][n] = __builtin_amdgcn_mfma_f32_16x16x32_bf16(Bt[n][k], At[m][k], acc[ai][bj][m][n], 0, 0, 0); __builtin_amdgcn_s_setprio(0); } while (0)
#define PG8_WAIT_V(n) asm volatile("s_waitcnt vmcnt(" #n ")" ::: "memory")
#define PG8_WAIT_L(n) asm volatile("s_waitcnt lgkmcnt(" #n ")" ::: "memory")
#define PG8_BAR __builtin_amdgcn_s_barrier()
#define PG8_SCHED __builtin_amdgcn_sched_barrier(0)
    Unit cur, nxt; int ui = 0;
    if (!g.next(0, G, c, cur)) return;
    f32x4 acc[2][2][4][2];
#pragma unroll
    for (int a = 0; a < 2; ++a)
#pragma unroll
        for (int b = 0; b < 2; ++b)
#pragma unroll
            for (int m = 0; m < 4; ++m)
#pragma unroll
                for (int n = 0; n < 2; ++n) acc[a][b][m][n] = (f32x4){0.f, 0.f, 0.f, 0.f};
    bf16x8 At[4][2], B0[2][2], B1[2][2];
    const char* cA = g.abase(cur); const char* cB = g.bbase(cur);
    PG8_STAGE(PG8_SB(0, 0), cB, voffB); PG8_STAGE(PG8_SB(0, 1), cB + hstepB, voffB); PG8_STAGE(PG8_SA(0, 0), cA, voffA); PG8_STAGE(PG8_SA(0, 1), cA + hstepA, voffA);
    if (wr == 1) PG8_BAR;
    PG8_WAIT_V(2); PG8_BAR;
    PG8_STAGE(PG8_SB(1, 0), cB + g.koffB(1), voffB); PG8_STAGE(PG8_SA(1, 0), cA + g.koffA(1), voffA); PG8_STAGE(PG8_SB(1, 1), cB + hstepB + g.koffB(1), voffB);
    PG8_WAIT_V(6); PG8_BAR;
    for (;;) {
        const bool has_next = g.next(ui + 1, G, c, nxt);
        const char* nA = has_next ? g.abase(nxt) : cA; const char* nB = has_next ? g.bbase(nxt) : cB;
#pragma nounroll
        for (int t = 0; t < nt; t += 2) {
            const bool last = (t == nt - 2);
            const char* a1 = cA + g.koffA(t + 1);
            const char* a2 = last ? nA : cA + g.koffA(t + 2); const char* b2 = last ? nB : cB + g.koffB(t + 2);
            const char* a3 = last ? nA + g.koffA(1) : cA + g.koffA(t + 3); const char* b3 = last ? nB + g.koffB(1) : cB + g.koffB(t + 3);
            if constexpr (Epi::MIDK >= 0) { if (t == Epi::MIDK) E.midk(acc, cur, wr, wc, fr, fq); }
            PG8_LDB(B0, 0, 0); PG8_LDB(B1, 0, 1); PG8_SCHED; PG8_LDA(At, 0, 0); PG8_STAGE(PG8_SA(1, 1), a1 + hstepA, voffA);
            PG8_WAIT_V(8); PG8_WAIT_L(0); PG8_BAR; PG8_MMA(0, 0, At, B0); PG8_MMA(0, 1, At, B1); PG8_BAR; PG8_SCHED;
            PG8_LDA(At, 0, 1); PG8_STAGE(PG8_SB(0, 0), b2, voffB); PG8_STAGE(PG8_SB(0, 1), b2 + hstepB, voffB); PG8_STAGE(PG8_SA(0, 0), a2, voffA);
            PG8_WAIT_V(8); PG8_WAIT_L(0); PG8_BAR; PG8_MMA(1, 0, At, B0); PG8_MMA(1, 1, At, B1); PG8_BAR; PG8_SCHED;
            PG8_LDB(B0, 1, 0); PG8_LDB(B1, 1, 1); PG8_SCHED; PG8_LDA(At, 1, 0); PG8_STAGE(PG8_SA(0, 1), a2 + hstepA, voffA);
            PG8_WAIT_V(8); PG8_WAIT_L(0); PG8_BAR; PG8_MMA(0, 0, At, B0); PG8_MMA(0, 1, At, B1); PG8_BAR; PG8_SCHED;
            PG8_LDA(At, 1, 1); PG8_STAGE(PG8_SB(1, 0), b3, voffB); PG8_STAGE(PG8_SB(1, 1), b3 + hstepB, voffB); PG8_STAGE(PG8_SA(1, 0), a3, voffA);
            PG8_WAIT_V(8); PG8_WAIT_L(0); PG8_BAR; PG8_MMA(1, 0, At, B0); PG8_MMA(1, 1, At, B1); PG8_BAR; PG8_SCHED;
        }
        if (wr == 0) PG8_BAR;
        E(acc, cur, wr, wc, fr, fq, lds);
        if (!has_next) break;
#pragma unroll
        for (int a = 0; a < 2; ++a)
#pragma unroll
            for (int b = 0; b < 2; ++b)
#pragma unroll
                for (int m = 0; m < 4; ++m)
#pragma unroll
                    for (int n = 0; n < 2; ++n) acc[a][b][m][n] = (f32x4){0.f, 0.f, 0.f, 0.f};
        cur = nxt; cA = nA; cB = nB; ++ui;
        if (wr == 1) PG8_BAR;
    }
    PG8_WAIT_V(0);
    PG8_BAR;
#undef PG8_SA
#undef PG8_SB
#undef PG8_STAGE
#undef pievoffA
#undef pievoffB
#undef PG8_LDA
#undef PG8_LDB
#undef PG8_MMA
#undef PG8_WAIT_V
#undef PG8_WAIT_L
#undef PG8_BAR
#undef PG8_SCHED
}
#define EPI_ARGS f32x4 (&acc)[2][2][4][2], const Unit& u, int wr, int wc, int fr, int fq
struct EpiBase { static constexpr int MIDK = -1; __device__ __forceinline__ void midk(EPI_ARGS) const {} };

struct EpiZ : EpiBase {
    bf16_t* U; bf16_t* XL; bf16_t* GG;
    __device__ __forceinline__ void operator()(EPI_ARGS, LAS unsigned char*) const {
        const int row0 = u.pm * BM + wr * 64 + fr;
#pragma unroll
        for (int ai = 0; ai < 2; ++ai)
#pragma unroll
            for (int m = 0; m < 4; ++m) {
                const int r = row0 + ai * HALF + m * 16, b = r >> 11, t = r & 2047;
#pragma unroll
                for (int bj = 0; bj < 2; ++bj) {
                    const int c = u.pn * BM + bj * HALF + wc * 32 + fq * 8;
                    f32x4 v0 = acc[ai][bj][m][0], v1 = acc[ai][bj][m][1];
                    if (u.pn < 2) {
                        const int g = c >> 4, hi0 = c & 15;
                        *(u32x4*)(U + ((size_t)(g * 1024 + b * NCH + (t >> 5)) * 640 + (t & 31) * 16 + hi0)) = pack8(v0, v1);
                    } else if (u.pn < 4) {
                        *(u32x4*)(XL + ((size_t)(b * XLROWS + 3 + t) * 512 + (c - 512))) = pack8(v0, v1);
                    } else {
#pragma unroll
                        for (int j = 0; j < 4; ++j) { v0[j] = gelu_t(v0[j]); v1[j] = gelu_t(v1[j]); }
                        *(u32x4*)(GG + ((size_t)r * 512 + (c - 1024))) = pack8(v0, v1);
                    }
                }
                asm volatile("" ::: "memory");
            }
    }
};
struct EpiBf16 : EpiBase {
    bf16_t* O; int ldc; int bdiv; long ob0, ob1;
    __device__ __forceinline__ void operator()(EPI_ARGS, LAS unsigned char*) const {
        bf16_t* base = O + (long)(u.pb / bdiv) * ob0 + (long)(u.pb % bdiv) * ob1;
        const int row0 = u.pm * BM + wr * 64 + fr;
#pragma unroll
        for (int ai = 0; ai < 2; ++ai)
#pragma unroll
            for (int m = 0; m < 4; ++m) {
                bf16_t* rowp = base + (size_t)(row0 + ai * HALF + m * 16) * ldc + u.pn * BM + wc * 32 + fq * 8;
#pragma unroll
                for (int bj = 0; bj < 2; ++bj) *(u32x4*)(rowp + bj * HALF) = pack8(acc[ai][bj][m][0], acc[ai][bj][m][1]);
            }
    }
};
struct EpiXend : EpiBase {
    float* X;
    __device__ __forceinline__ void operator()(EPI_ARGS, LAS unsigned char*) const {
        const int row0 = u.pm * BM + wr * 64 + fr;
#pragma unroll
        for (int ai = 0; ai < 2; ++ai)
#pragma unroll
            for (int m = 0; m < 4; ++m) {
                float* rowp = X + ((size_t)u.pb * 1024 + row0 + ai * HALF + m * 16) * 128 + wc * 32 + fq * 8;
                *(f32x4*)(rowp) = acc[ai][0][m][0]; *(f32x4*)(rowp + 4) = acc[ai][0][m][1];
            }
    }
};
struct EpiGates : EpiBase {
    const bf16_t* XL; const float* cw; const float* cb; const float* gbias; const float* sp8; float* LA; float* LB;
    __device__ __forceinline__ void operator()(EPI_ARGS, LAS unsigned char*) const {
        const int hp = u.pb >> 4, b = u.pb & 15, rt = u.pm;
        const int ch0 = hp * 128 + wc * 32 + fq * 8;
        const float* gb = gbias + hp * 256 + wc * 32 + fq * 8;
        f32x4 cbv[2], ba[2], bx[2], spv[2];
#pragma unroll
        for (int n = 0; n < 2; ++n) { cbv[n] = *(const f32x4*)(cb + ch0 + 4 * n); ba[n] = *(const f32x4*)(gb + 4 * n); bx[n] = *(const f32x4*)(gb + 128 + 4 * n); spv[n] = *(const f32x4*)(sp8 + ch0 + 4 * n); }
#pragma unroll
        for (int ai = 0; ai < 2; ++ai)
#pragma unroll
            for (int mp = 0; mp < 2; ++mp) {
                u32x4 xw[2][4];
#pragma unroll
                for (int mm = 0; mm < 2; ++mm) { const int t = rt * 256 + ai * HALF + wr * 64 + (mp * 2 + mm) * 16 + fr; const bf16_t* xr = XL + ((size_t)(b * XLROWS + t) * 512 + ch0);
#pragma unroll
                    for (int k = 0; k < 4; ++k) xw[mm][k] = *(const u32x4*)(xr + (size_t)k * 512); }
#pragma unroll
                for (int mm = 0; mm < 2; ++mm) {
                    const int m = mp * 2 + mm;
                    const int t = rt * 256 + ai * HALF + wr * 64 + m * 16 + fr;
                    const size_t o = ((size_t)(b * S + t)) * 512 + ch0;
#pragma unroll
                    for (int n = 0; n < 2; ++n) {
                        f32x4 xc = cbv[n];
#pragma unroll
                        for (int k = 0; k < 4; ++k) { const f32x4 w = *(const f32x4*)(cw + k * 512 + ch0 + 4 * n); const unsigned w0 = n ? xw[mm][k].z : xw[mm][k].x, w1 = n ? xw[mm][k].w : xw[mm][k].y;
                            xc[0] += w[0] * bflo(w0); xc[1] += w[1] * bfhi(w0); xc[2] += w[2] * bflo(w1); xc[3] += w[3] * bfhi(w1); }
                        f32x4 av, bv;
#pragma unroll
                        for (int j = 0; j < 4; ++j) {
                            const float r = sigm(acc[ai][0][m][n][j] + ba[n][j]), ig = sigm(acc[ai][1][m][n][j] + bx[n][j]);
                            const float la = -r * spv[n][j];
                            const float a = fast_exp(la);
                            const float x2 = 2.0f * la;
                            const float om = (x2 > -0.1f) ? (-x2 * (1.0f + x2 * (0.5f + x2 * (0.16666667f + x2 * 0.041666668f)))) : (1.0f - a * a);
                            av[j] = a; bv[j] = __builtin_sqrtf(om) * ig * xc[j];
                        }
                        *(f32x4*)(LA + o + 4 * n) = av; *(f32x4*)(LB + o + 4 * n) = bv;
                    }
                }
                asm volatile("" ::: "memory");
            }
    }
};
struct EpiS5 : EpiBase {
    const bf16_t* U; const float* dd; bf16_t* Y1;
    __device__ __forceinline__ void operator()(EPI_ARGS, LAS unsigned char*) const {
        const int g = u.pb; const int row0 = u.pm * BM + wr * 64 + fr;
#pragma unroll
        for (int bj = 0; bj < 2; ++bj) {
            const int c = u.pn * BM + bj * HALF + wc * 32 + fq * 8, i = c >> 4, ho0 = c & 15;
            const f32x4 d0 = *(const f32x4*)(dd + g * 16 + ho0), d1 = *(const f32x4*)(dd + g * 16 + ho0 + 4);
#pragma unroll
            for (int ai = 0; ai < 2; ++ai) {
                u32x4 uw[4];
#pragma unroll
                for (int m = 0; m < 4; ++m) { const int R = row0 + ai * HALF + m * 16; uw[m] = *(const u32x4*)(U + ((size_t)(g * 1024 + R) * 640 + c)); }
#pragma unroll
                for (int m = 0; m < 4; ++m) {
                    const int R = row0 + ai * HALF + m * 16, b = R >> 6, chn = R & 63;
                    f32x4 u0, u1; unpack8(uw[m], u0, u1);
                    f32x4 v0 = acc[ai][bj][m][0] + d0 * u0, v1 = acc[ai][bj][m][1] + d1 * u1;
#pragma unroll
                    for (int j = 0; j < 4; ++j) { v0[j] = gelu_t(v0[j]); v1[j] = gelu_t(v1[j]); }
                    *(u32x4*)(Y1 + ((size_t)(b * S + chn * CH + i) * 512 + g * 16 + ho0)) = pack8(v0, v1);
                }
                asm volatile("" ::: "memory");
            }
        }
    }
};
struct EpiGlu : EpiBase {
    const bf16_t* Y1; const float* bg; bf16_t* YC; float* ssq;
    __device__ __forceinline__ void operator()(EPI_ARGS, LAS unsigned char*) const {
        const int row0 = u.pm * BM + wr * 64 + fr;
        float ss[2][4];
#pragma unroll
        for (int ai = 0; ai < 2; ++ai)
#pragma unroll
            for (int m = 0; m < 4; ++m) ss[ai][m] = 0.f;
#pragma unroll
        for (int bj = 0; bj < 2; ++bj) {
            const int c = u.pn * BM + bj * HALF + wc * 32 + fq * 8;
            const f32x4 g0 = *(const f32x4*)(bg + c), g1 = *(const f32x4*)(bg + c + 4);
#pragma unroll
            for (int ai = 0; ai < 2; ++ai) {
                u32x4 yw[4];
#pragma unroll
                for (int m = 0; m < 4; ++m) { const size_t r = row0 + ai * HALF + m * 16; yw[m] = *(const u32x4*)(Y1 + r * 512 + c); }
#pragma unroll
                for (int m = 0; m < 4; ++m) {
                    const size_t r = row0 + ai * HALF + m * 16;
                    f32x4 y0, y1; unpack8(yw[m], y0, y1);
                    f32x4 v0, v1;
#pragma unroll
                    for (int j = 0; j < 4; ++j) { v0[j] = y0[j] * sigm(acc[ai][bj][m][0][j] + g0[j]); v1[j] = y1[j] * sigm(acc[ai][bj][m][1][j] + g1[j]); ss[ai][m] += v0[j] * v0[j] + v1[j] * v1[j]; }
                    *(u32x4*)(YC + r * 1024 + c) = pack8(v0, v1);
                }
                asm volatile("" ::: "memory");
            }
        }
#pragma unroll
        for (int ai = 0; ai < 2; ++ai)
#pragma unroll
            for (int m = 0; m < 4; ++m) { float s = ss[ai][m]; s += __shfl_xor(s, 16); s += __shfl_xor(s, 32); if (fq == 0) atomicAdd(ssq + row0 + ai * HALF + m * 16, s); }
    }
};
template <int MODE, bool HASF, bool HASB, int MK>
struct EpiRes {
    static constexpr int MIDK = MK;
    const float* prev; const bf16_t* prevb; const float* pstats; const float* pg; const float* pb_; float* vout; bf16_t* vb; float* ostats; const float* ssq;
    __device__ __forceinline__ void midk(EPI_ARGS) const {
        const int row0 = u.pm * BM + wr * 64 + fr;
#pragma unroll
        for (int ai = 0; ai < 2; ++ai)
#pragma unroll
            for (int m = 0; m < 4; ++m) { const float s = __builtin_amdgcn_rsqf(ssq[row0 + ai * HALF + m * 16] * (1.0f / 512.0f) + 1e-6f);
#pragma unroll
                for (int bj = 0; bj < 2; ++bj)
#pragma unroll
                    for (int n = 0; n < 2; ++n) acc[ai][bj][m][n] = acc[ai][bj][m][n] * s; }
    }
    __device__ __forceinline__ void operator()(EPI_ARGS, LAS unsigned char*) const {
        const int row0 = u.pm * BM + wr * 64 + fr;
#pragma unroll
        for (int ai = 0; ai < 2; ++ai) {
            float s1[4], s2[4];
#pragma unroll
            for (int m = 0; m < 4; ++m) { s1[m] = 0.f; s2[m] = 0.f; }
#pragma unroll
            for (int bj = 0; bj < 2; ++bj) {
                const int c = u.pn * BM + bj * HALF + wc * 32 + fq * 8;
                const f32x4 g0 = *(const f32x4*)(pg + c), g1 = *(const f32x4*)(pg + c + 4), b0 = *(const f32x4*)(pb_ + c), b1 = *(const f32x4*)(pb_ + c + 4);
                f32x2 st[4]; f32x4 p0[4], p1[4];
#pragma unroll
                for (int m = 0; m < 4; ++m) { const int r = row0 + ai * HALF + m * 16; st[m] = *(const f32x2*)(pstats + 2 * (size_t)r);
                    const size_t o = (size_t)r * 1024 + c;
                    if (MODE == 0) { p0[m] = *(const f32x4*)(prev + o); p1[m] = *(const f32x4*)(prev + o + 4); }
                    else { const u32x4 w = *(const u32x4*)(prevb + o); unpack8(w, p0[m], p1[m]); } }
#pragma unroll
                for (int m = 0; m < 4; ++m) {
                    const int r = row0 + ai * HALF + m * 16;
                    float mm, rr;
                    if (MODE == 0) { mm = st[m].x; rr = st[m].y; }
                    else { mm = st[m].x * (1.0f / 1024.0f); rr = __builtin_amdgcn_rsqf(st[m].y * (1.0f / 1024.0f) - mm * mm + 1e-5f); }
                    const size_t o = (size_t)r * 1024 + c;
                    const f32x4 v0 = ((p0[m] - mm) * rr * g0 + b0) * ALPHA + acc[ai][bj][m][0], v1 = ((p1[m] - mm) * rr * g1 + b1) * ALPHA + acc[ai][bj][m][1];
                    if (HASF) { *(f32x4*)(vout + o) = v0; *(f32x4*)(vout + o + 4) = v1; }
                    if (HASB) *(u32x4*)(vb + o) = pack8(v0, v1);
#pragma unroll
                    for (int j = 0; j < 4; ++j) { s1[m] += v0[j] + v1[j]; s2[m] += v0[j] * v0[j] + v1[j] * v1[j]; }
                }
                asm volatile("" ::: "memory");
            }
#pragma unroll
            for (int m = 0; m < 4; ++m) { float a = s1[m], q = s2[m]; a += __shfl_xor(a, 16); a += __shfl_xor(a, 32); q += __shfl_xor(q, 16); q += __shfl_xor(q, 32);
                if (fq == 0) { float* d = ostats + 2 * (size_t)(row0 + ai * HALF + m * 16); atomicAdd(d, a); atomicAdd(d + 1, q); } }
            asm volatile("" ::: "memory");
        }
    }
};
template <int ACT>
struct EpiFold : EpiBase {
    const float* pstats; const float* c1; const float* c2; bf16_t* O; int ldc; float sc;
    __device__ __forceinline__ void operator()(EPI_ARGS, LAS unsigned char*) const {
        const int row0 = u.pm * BM + wr * 64 + fr;
        float mu[2][4], rs[2][4];
#pragma unroll
        for (int ai = 0; ai < 2; ++ai)
#pragma unroll
            for (int m = 0; m < 4; ++m) { const f32x2 st = *(const f32x2*)(pstats + 2 * (size_t)(row0 + ai * HALF + m * 16));
                const float mm = st.x * (1.0f / 1024.0f); mu[ai][m] = mm; rs[ai][m] = __builtin_amdgcn_rsqf(st.y * (1.0f / 1024.0f) - mm * mm + 1e-5f); }
#pragma unroll
        for (int bj = 0; bj < 2; ++bj) {
            const int c = u.pn * BM + bj * HALF + wc * 32 + fq * 8;
            const f32x4 k0 = *(const f32x4*)(c1 + c), k1 = *(const f32x4*)(c1 + c + 4), e0 = *(const f32x4*)(c2 + c), e1 = *(const f32x4*)(c2 + c + 4);
#pragma unroll
            for (int ai = 0; ai < 2; ++ai)
#pragma unroll
                for (int m = 0; m < 4; ++m) {
                    const float mm = mu[ai][m], rr = rs[ai][m];
                    f32x4 v0 = (acc[ai][bj][m][0] - k0 * mm) * rr + e0, v1 = (acc[ai][bj][m][1] - k1 * mm) * rr + e1;
                    if (ACT == 0) { v0 = v0 * sc; v1 = v1 * sc; }
                    else {
#pragma unroll
                        for (int j = 0; j < 4; ++j) { const float a = fmaxf(v0[j], 0.f), b = fmaxf(v1[j], 0.f); v0[j] = a * a; v1[j] = b * b; } }
                    *(u32x4*)(O + (size_t)(row0 + ai * HALF + m * 16) * ldc + c) = pack8(v0, v1);
                    asm volatile("" ::: "memory");
                }
        }
    }
};
struct EpiSoftmax : EpiBase {
    bf16_t* P;
    __device__ __forceinline__ void operator()(EPI_ARGS, LAS unsigned char* lds) const {
        LAS f32x2* X = (LAS f32x2*)(lds + LDS_X);
        float mw[2][4];
#pragma unroll
        for (int ai = 0; ai < 2; ++ai)
#pragma unroll
            for (int m = 0; m < 4; ++m) {
                float mx = -3.0e38f;
#pragma unroll
                for (int bj = 0; bj < 2; ++bj)
#pragma unroll
                    for (int n = 0; n < 2; ++n)
#pragma unroll
                        for (int j = 0; j < 4; ++j) mx = fmaxf(mx, acc[ai][bj][m][n][j]);
                mx = fmaxf(mx, __shfl_xor(mx, 16)); mx = fmaxf(mx, __shfl_xor(mx, 32));
                float sm = 0.f;
#pragma unroll
                for (int bj = 0; bj < 2; ++bj)
#pragma unroll
                    for (int n = 0; n < 2; ++n)
#pragma unroll
                        for (int j = 0; j < 4; ++j) { const float e = fast_exp(acc[ai][bj][m][n][j] - mx); acc[ai][bj][m][n][j] = e; sm += e; }
                sm += __shfl_xor(sm, 16); sm += __shfl_xor(sm, 32);
                mw[ai][m] = mx;
                if (fq == 0) X[(ai * HALF + wr * 64 + m * 16 + fr) * 4 + wc] = (f32x2){mx, sm};
            }
        asm volatile("s_waitcnt lgkmcnt(0)" ::: "memory"); __builtin_amdgcn_s_barrier(); asm volatile("" ::: "memory");
        const int row0 = u.pm * BM + wr * 64 + fr;
#pragma unroll
        for (int ai = 0; ai < 2; ++ai)
#pragma unroll
            for (int m = 0; m < 4; ++m) {
                const int rl = ai * HALF + wr * 64 + m * 16 + fr;
                const f32x2 x0 = X[rl * 4 + 0], x1 = X[rl * 4 + 1], x2 = X[rl * 4 + 2], x3 = X[rl * 4 + 3];
                const float Mx = fmaxf(fmaxf(x0.x, x1.x), fmaxf(x2.x, x3.x));
                const float tot = x0.y * fast_exp(x0.x - Mx) + x1.y * fast_exp(x1.x - Mx) + x2.y * fast_exp(x2.x - Mx) + x3.y * fast_exp(x3.x - Mx);
                const float scl = fast_exp(mw[ai][m] - Mx) * fast_rcp(tot);
                bf16_t* rowp = P + ((size_t)u.pb * S + row0 + ai * HALF + m * 16) * 256 + wc * 32 + fq * 8;
#pragma unroll
                for (int bj = 0; bj < 2; ++bj) *(u32x4*)(rowp + bj * HALF) = pack8(acc[ai][bj][m][0] * scl, acc[ai][bj][m][1] * scl);
            }
        asm volatile("s_waitcnt lgkmcnt(0)" ::: "memory");
    }
};
struct Params { const float* in[39]; float* out; unsigned char* ws; int ph_lo, ph_hi; };
typedef const Params __attribute__((address_space(4)))* KP;
__device__ __forceinline__ KP kargs() { KP q = (KP)__builtin_amdgcn_kernarg_segment_ptr(); asm volatile("" : "+s"(q)); return q; }

__device__ __forceinline__ void p0_tile_wave(const float* __restrict__ W, int K, int N, const float* sA, const float* sB, int split, const float* lb, float* c1p, float* c2p,
                                             bf16_t* __restrict__ Wt, int tile, LAS float* scr, int lane) {
    const int tiles_n = N >> 6, tk = tile / tiles_n, tn = tile % tiles_n, k0 = tk * 64, n0 = tn * 64;
    f32x4 v[16];
#pragma unroll
    for (int i = 0; i < 16; ++i) v[i] = *(const f32x4*)(W + (size_t)(k0 + i * 4 + (lane >> 4)) * N + n0 + (lane & 15) * 4);
#pragma unroll
    for (int i = 0; i < 16; ++i) { LAS float* d = scr + (i * 4 + (lane >> 4)) * 65 + (lane & 15) * 4; d[0] = v[i][0]; d[1] = v[i][1]; d[2] = v[i][2]; d[3] = v[i][3]; }
    asm volatile("s_waitcnt lgkmcnt(0)" ::: "memory");
    const int kc = lane & 7, kb = k0 + kc * 8;
    f32x4 s0 = (f32x4){1.f, 1.f, 1.f, 1.f}, s1 = s0;
    if (sA) { const float* sp = (kb < split) ? (sA + kb) : (sB + (kb - split)); s0 = *(const f32x4*)sp; s1 = *(const f32x4*)(sp + 4); }
    f32x4 l0 = (f32x4){0.f, 0.f, 0.f, 0.f}, l1 = l0;
    if (lb) { l0 = *(const f32x4*)(lb + kb); l1 = *(const f32x4*)(lb + kb + 4); }
#pragma unroll
    for (int ps = 0; ps < 8; ++ps) {
        const int n = ps * 8 + (lane >> 3); f32x4 a, b;
#pragma unroll
        for (int j = 0; j < 4; ++j) { a[j] = scr[(kc * 8 + j) * 65 + n]; b[j] = scr[(kc * 8 + 4 + j) * 65 + n]; }
        const f32x4 as = a * s0, bs = b * s1; const u32x4 w = pack8(as, bs);
        *(u32x4*)(Wt + (size_t)(n0 + n) * K + kb) = w;
        if (lb) {
            f32x4 ra, rb; unpack8(w, ra, rb);
            float c1 = (ra[0] + ra[1]) + (ra[2] + ra[3]) + (rb[0] + rb[1]) + (rb[2] + rb[3]);
            float c2 = (a[0] * l0[0] + a[1] * l0[1]) + (a[2] * l0[2] + a[3] * l0[3]) + (b[0] * l1[0] + b[1] * l1[1]) + (b[2] * l1[2] + b[3] * l1[3]);
            c1 += __shfl_xor(c1, 1); c1 += __shfl_xor(c1, 2); c1 += __shfl_xor(c1, 4); c2 += __shfl_xor(c2, 1); c2 += __shfl_xor(c2, 2); c2 += __shfl_xor(c2, 4);
            if (kc == 0) { c1p[(size_t)tk * N + n0 + n] = c1; c2p[(size_t)tk * N + n0 + n] = c2; }
        }
    }
    asm volatile("s_waitcnt lgkmcnt(0)" ::: "memory");
}
__device__ __forceinline__ void p0_ln_rows(KP p, unsigned char* ws, int V, int NV, int lane) {
    constexpr int NR = M + 4096;
    const float* xin = p->in[0]; const float* min_ = p->in[1];
    auto src = [&](int r) -> const float* { return r < M ? xin + (size_t)r * 1024 : min_ + (size_t)(r - M) * 1024; };
    if (V >= NR) return;
    f32x4 nv[4];
#pragma unroll
    for (int j = 0; j < 4; ++j) nv[j] = *(const f32x4*)(src(V) + j * 256 + lane * 4);
    for (int r = V; r < NR; r += NV) {
        f32x4 v[4];
#pragma unroll
        for (int j = 0; j < 4; ++j) v[j] = nv[j];
        const int rn = r + NV;
        if (rn < NR) {
#pragma unroll
            for (int j = 0; j < 4; ++j) nv[j] = *(const f32x4*)(src(rn) + j * 256 + lane * 4); }
        float s = 0.f;
#pragma unroll
        for (int j = 0; j < 4; ++j) s += (v[j][0] + v[j][1]) + (v[j][2] + v[j][3]);
        const float mu = wave_sum(s) * (1.0f / 1024.0f); float q = 0.f;
#pragma unroll
        for (int j = 0; j < 4; ++j) { v[j] = v[j] - mu; q += (v[j][0] * v[j][0] + v[j][1] * v[j][1]) + (v[j][2] * v[j][2] + v[j][3] * v[j][3]); }
        const float rstd = rsqrtf(wave_sum(q) * (1.0f / 1024.0f) + 1e-5f);
        const bool isx = r < M; const float* g = isx ? p->in[2] : p->in[27]; const float* b = isx ? p->in[3] : p->in[28];
        bf16_t* o = isx ? (bf16_t*)(ws + WS_H0B) + (size_t)r * 1024 : (bf16_t*)(ws + WS_MEMN) + (size_t)(r - M) * 1024;
#pragma unroll
        for (int j = 0; j < 4; ++j) { const f32x4 gg = *(const f32x4*)(g + j * 256 + lane * 4), bb = *(const f32x4*)(b + j * 256 + lane * 4); const f32x4 y = v[j] * rstd * gg + bb;
            u32x2 w; w.x = cvt_pk_bf16(y[0], y[1]); w.y = cvt_pk_bf16(y[2], y[3]); *(u32x2*)(o + j * 256 + lane * 4) = w; }
        if (isx && lane == 0) { float* st = (float*)(ws + WS_STATS0) + 2 * (size_t)r; st[0] = mu; st[1] = rstd; }
    }
}
__device__ __forceinline__ void p0_s5_tables(KP p, int g, LAS unsigned char* lds, int tid) {
    LAS float* lam = (LAS float*)lds;
    LAS float* Bb = lam + 33 * 128;
    LAS float* Cc = Bb + 2048;
    LAS float* Kt = Cc + 2048;
    const float* a_re = p->in[5] + g * 64; const float* a_im = p->in[6] + g * 64; const float dt = expf(p->in[7][g]);
    for (int i = tid; i < 33 * 64; i += NTHREADS) { const int tau = i >> 6, pp = i & 63; const float mag = expf((float)tau * dt * a_re[pp]); float sn, cs; sincosf((float)tau * dt * a_im[pp], &sn, &cs);
        lam[i * 2] = mag * cs; lam[i * 2 + 1] = mag * sn; }
    for (int i = tid; i < 1024; i += NTHREADS) { const int pp = i >> 4, h = i & 15;
        const float ar = a_re[pp], ai = a_im[pp]; const float mag = expf(dt * ar); float sn, cs; sincosf(dt * ai, &sn, &cs); const float lr = mag * cs, li = mag * sn;
        const float den = ar * ar + ai * ai; const float qr = ((lr - 1.f) * ar + li * ai) / den, qi = (li * ar - (lr - 1.f) * ai) / den;
        const float br = p->in[8][(g * 64 + pp) * 16 + h], bi = p->in[9][(g * 64 + pp) * 16 + h];
        Bb[i * 2] = qr * br - qi * bi; Bb[i * 2 + 1] = qr * bi + qi * br;
        const int ho = i >> 6, p2 = i & 63; Cc[i * 2] = p->in[10][(g * 16 + ho) * 64 + p2]; Cc[i * 2 + 1] = p->in[11][(g * 16 + ho) * 64 + p2]; }
    __syncthreads();
    { const int e = tid >> 1, ho = e >> 4, hi = e & 15, half = tid & 1;
      f32x2 cb[32];
#pragma unroll
      for (int q = 0; q < 32; ++q) { const int pp = half * 32 + q; const f32x2 cc = *(LAS f32x2*)(Cc + (ho * 64 + pp) * 2), bb = *(LAS f32x2*)(Bb + (pp * 16 + hi) * 2);
          cb[q] = (f32x2){cc.x * bb.x - cc.y * bb.y, cc.x * bb.y + cc.y * bb.x}; }
      for (int tau = 0; tau < 32; ++tau) { float s = 0.f;
#pragma unroll
          for (int q = 0; q < 32; ++q) { const f32x2 l = *(LAS f32x2*)(lam + (tau * 64 + half * 32 + q) * 2); s += cb[q].x * l.x - cb[q].y * l.y; }
          s += __shfl_xor(s, 1); if (half == 0) Kt[tau * 256 + e] = s; } }
    __syncthreads();
    bf16_t* T = (bf16_t*)(p->ws + WS_S5T) + (size_t)g * 512 * 640;
    for (int q = tid; q < 512 * 80; q += NTHREADS) { const int n = q / 80, kc = q % 80, i = n >> 4, ho = n & 15; f32x4 a, b;
        if (kc < 64) { const int j = kc >> 1, hi0 = (kc & 1) * 8;
            if (i >= j) { LAS float* src = Kt + (i - j) * 256 + ho * 16 + hi0; a = *(LAS f32x4*)src; b = *(LAS f32x4*)(src + 4); }
            else { a = (f32x4){0.f, 0.f, 0.f, 0.f}; b = a; } }
        else { const int p0 = (kc - 64) * 4;
#pragma unroll
            for (int x = 0; x < 4; ++x) { const int pp = p0 + x; const float cr = Cc[(ho * 64 + pp) * 2], ci = Cc[(ho * 64 + pp) * 2 + 1], lr = lam[((i + 1) * 64 + pp) * 2], li = lam[((i + 1) * 64 + pp) * 2 + 1];
                const float re = cr * lr - ci * li, im = cr * li + ci * lr; if (x < 2) { a[2 * x] = re; a[2 * x + 1] = -im; } else { b[2 * (x - 2)] = re; b[2 * (x - 2) + 1] = -im; } } }
        *(u32x4*)(T + (size_t)n * 640 + kc * 8) = pack8(a, b); }
    bf16_t* Pm = (bf16_t*)(p->ws + WS_S5P) + (size_t)g * 256 * 512;
    for (int q = tid; q < 256 * 64; q += NTHREADS) { const int n = q >> 6, kc = q & 63; f32x4 a = (f32x4){0.f, 0.f, 0.f, 0.f}, b = a;
        if (n < 128) { const int pp = n >> 1, im = n & 1, j = kc >> 1, hi0 = (kc & 1) * 8; const float lr = lam[((CH - 1 - j) * 64 + pp) * 2], li = lam[((CH - 1 - j) * 64 + pp) * 2 + 1];
#pragma unroll
            for (int x = 0; x < 8; ++x) { const float br = Bb[(pp * 16 + hi0 + x) * 2], bi = Bb[(pp * 16 + hi0 + x) * 2 + 1]; const float v = im ? (lr * bi + li * br) : (lr * br - li * bi); if (x < 4) a[x] = v; else b[x - 4] = v; } }
        *(u32x4*)(Pm + (size_t)n * 512 + kc * 8) = pack8(a, b); }
    if (tid < 128) ((float*)(p->ws + WS_LAML))[g * 128 + tid] = lam[CH * 128 + tid];
    __syncthreads();
}
__device__ __forceinline__ void p0_prep(KP p, LAS unsigned char* lds, int G, int c, int wv) {
    const int lane = lane_id(), wave = wv, tid = wv * 64 + lane;
    unsigned char* ws = p->ws;
    const int NS = (G > 64) ? 32 : 0;
    if (c < NS || NS == 0) {
        constexpr int I_GT = 128, I_GB = 2, I_SP = 1, I_Z = 112 + 6, NSM = I_GT + I_GB + I_SP + I_Z;
        const int step = NS ? NS : G;
        for (int it = c; it < NSM; it += step) {
            int r = it;
            if (r < I_GT) {
                const int q = r * 512 + tid, hp = q >> 14, n = (q >> 6) & 255, k0 = (q & 63) * 8;
                const int tap = k0 >> 7, cc0 = k0 & 127, co = hp * 128 + (n & 127), ho = co >> 6; const float* Wg = (n >> 7) ? p->in[19] : p->in[17];
                f32x4 a = (f32x4){0.f, 0.f, 0.f, 0.f}, b = a;
                if (((hp * 128 + cc0) >> 6) == ho) {
#pragma unroll
                    for (int x = 0; x < 8; ++x) { const int ci = hp * 128 + cc0 + x; const float v = p->in[15][tap * 512 + ci] * Wg[(ho * 64 + (ci & 63)) * 64 + (co & 63)]; if (x < 4) a[x] = v; else b[x - 4] = v; } }
                *(u32x4*)((bf16_t*)(ws + WS_GATES) + ((size_t)(hp * 256 + n) * 512 + k0)) = pack8(a, b);
                continue;
            } r -= I_GT;
            if (r < I_GB) { const int q = r * 512 + tid, hp = q >> 8, n = q & 255, co = hp * 128 + (n & 127), ho = co >> 6; const float* Wg = (n >> 7) ? p->in[19] : p->in[17];
                float s = ((n >> 7) ? p->in[20] : p->in[18])[co];
#pragma unroll 8
                for (int i = 0; i < 64; ++i) s += p->in[16][ho * 64 + i] * Wg[(ho * 64 + i) * 64 + (co & 63)];
                ((float*)(ws + WS_GBIAS))[q] = s; continue; } r -= I_GB;
            if (r < I_SP) { ((float*)(ws + WS_SP8))[tid] = 8.0f * log1pf(expf(-p->in[21][tid])); continue; } r -= I_SP;
            if (r < 112) *(u32x4*)(ws + WS_ZERO_BEG + ((size_t)r * 512 + tid) * 16) = (u32x4){0u, 0u, 0u, 0u};
            else { const int q = (r - 112) * 512 + tid;
                const int b = q / 192, w = q % 192; *(u32x4*)(ws + WS_XL + ((size_t)b * XLROWS * 512) * 2 + (size_t)w * 16) = (u32x4){0u, 0u, 0u, 0u}; }
        }
        for (int g = c; g < NG; g += step) p0_s5_tables(p, g, lds, tid);
        if (NS) return;
    }
    const int V = (c - NS) * 8 + wave, NV = (G - NS) * 8;
    LAS float* scr = (LAS float*)(lds + wave * 16640);
    constexpr int T_IN = 16 * 24, T_GLU = 64, T_SQ = 256, T_F1 = 16 * 64, T_F2 = 64 * 16, I_TR = T_IN + T_GLU + 5 * T_SQ + T_F1 + T_F2;
    for (int it = V; it < I_TR; it += NV) {
        int r = it;
        if (r < T_IN) { p0_tile_wave(p->in[4], 1024, 1536, nullptr, nullptr, 0, nullptr, nullptr, nullptr, (bf16_t*)(ws + WS_WIN), r, scr, lane); continue; } r -= T_IN;
        if (r < T_SQ) { p0_tile_wave(p->in[30], 1024, 1024, nullptr, nullptr, 0, nullptr, nullptr, nullptr, (bf16_t*)(ws + WS_WK), r, scr, lane); continue; } r -= T_SQ;
        if (r < T_SQ) { p0_tile_wave(p->in[31], 1024, 1024, nullptr, nullptr, 0, nullptr, nullptr, nullptr, (bf16_t*)(ws + WS_WV), r, scr, lane); continue; } r -= T_SQ;
        if (r < T_GLU) { p0_tile_wave(p->in[13], 512, 512, nullptr, nullptr, 0, nullptr, nullptr, nullptr, (bf16_t*)(ws + WS_WGLU), r, scr, lane); continue; } r -= T_GLU;
        if (r < T_SQ) { p0_tile_wave(p->in[24], 1024, 1024, p->in[22], p->in[23], 512, nullptr, nullptr, nullptr, (bf16_t*)(ws + WS_WMIX), r, scr, lane); continue; } r -= T_SQ;
        if (r < T_SQ) { p0_tile_wave(p->in[29], 1024, 1024, p->in[25], p->in[25], 1 << 30, p->in[26], (float*)(ws + WS_CPART), (float*)(ws + WS_CPART) + 16 * 1024, (bf16_t*)(ws + WS_WQ), r, scr, lane); continue; } r -= T_SQ;
        if (r < T_SQ) { p0_tile_wave(p->in[32], 1024, 1024, nullptr, nullptr, 0, nullptr, nullptr, nullptr, (bf16_t*)(ws + WS_WO), r, scr, lane); continue; } r -= T_SQ;
        if (r < T_F1) { p0_tile_wave(p->in[35], 1024, 4096, p->in[33], p->in[33], 1 << 30, p->in[34], (float*)(ws + WS_CPART) + 32 * 1024, (float*)(ws + WS_CPART) + 32 * 1024 + 16 * 4096, (bf16_t*)(ws + WS_WF1), r, scr, lane); continue; } r -= T_F1;
        p0_tile_wave(p->in[36], 4096, 1024, nullptr, nullptr, 0, nullptr, nullptr, nullptr, (bf16_t*)(ws + WS_WF2), r, scr, lane);
    }
    p0_ln_rows(p, ws, V, NV, lane);
}
__device__ __forceinline__ void p3_colsum_reduce(KP p, int c, int wv) {
    const int col = (c - 64) * NTHREADS + TID(wv); if (c < 64 || col >= 5120) return;
    const float* cp = (const float*)(p->ws + WS_CPART); float a = 0.f, b = 0.f;
    if (col < 1024) {
#pragma unroll
        for (int t = 0; t < 16; ++t) { a += cp[t * 1024 + col]; b += cp[16 * 1024 + t * 1024 + col]; }
        ((float*)(p->ws + WS_C1Q))[col] = a; ((float*)(p->ws + WS_C2Q))[col] = b;
    } else { const int cc = col - 1024; const float* cq = cp + 32 * 1024;
#pragma unroll
        for (int t = 0; t < 16; ++t) { a += cq[t * 4096 + cc]; b += cq[16 * 4096 + t * 4096 + cc]; }
        ((float*)(p->ws + WS_C1F))[cc] = a; ((float*)(p->ws + WS_C2F))[cc] = b; }
}
__device__ __forceinline__ void p3_s5_scan(KP p, int c, int wv) {
    const int gt = c * NTHREADS + TID(wv); if (gt >= NG * B * 64) return;
    const int g = gt >> 10, b = (gt >> 6) & 15, pp = gt & 63;
    const float lr = ((const float*)(p->ws + WS_LAML))[g * 128 + pp * 2], li = ((const float*)(p->ws + WS_LAML))[g * 128 + pp * 2 + 1];
    const float* xe = (const float*)(p->ws + WS_XEND) + ((size_t)(g * 1024 + b * NCH)) * 128 + 2 * pp;
    bf16_t* uo = (bf16_t*)(p->ws + WS_U) + ((size_t)(g * 1024 + b * NCH)) * 640 + 512 + 2 * pp;
    float xr = 0.f, xi = 0.f;
    for (int c0 = 0; c0 < NCH; c0 += 8) {
        f32x2 e[8];
#pragma unroll
        for (int j = 0; j < 8; ++j) e[j] = *(const f32x2*)(xe + (size_t)(c0 + j) * 128);
#pragma unroll
        for (int j = 0; j < 8; ++j) { *(unsigned*)(uo + (size_t)(c0 + j) * 640) = cvt_pk_bf16(xr, xi);
            const float nr = lr * xr - li * xi + e[j].x, ni = lr * xi + li * xr + e[j].y; xr = nr; xi = ni; }
    }
}
constexpr int LG = 128, NLG = S / LG;
__device__ __forceinline__ void p3_lru_pass1(KP p, int G, int c, int wv) {
    const int ch = TID(wv); const float* LA = (const float*)(p->ws + WS_LA); const float* LB = (const float*)(p->ws + WS_LB); float* agg = (float*)(p->ws + WS_AGG);
    for (int it = c; it < B * NLG; it += G) {
        const size_t base = (size_t)it * LG * 512 + ch; float A = 1.f, h = 0.f;
        for (int t0 = 0; t0 < LG; t0 += 16) {
            float av[16], bv[16];
#pragma unroll
            for (int t = 0; t < 16; ++t) { av[t] = LA[base + (size_t)(t0 + t) * 512]; bv[t] = LB[base + (size_t)(t0 + t) * 512]; }
#pragma unroll
            for (int t = 0; t < 16; ++t) { h = av[t] * h + bv[t]; A *= av[t]; }
        }
        agg[((size_t)it * 2) * 512 + ch] = A; agg[((size_t)it * 2 + 1) * 512 + ch] = h;
    }
}
__device__ __forceinline__ void p4_lru_pass2(KP p, LAS unsigned char* lds, int G, int c, int wv) {
    const int lane = lane_id(), wave = wv, ch = wv * 64 + lane; LAS float* yb = (LAS float*)lds;
    const float* LA = (const float*)(p->ws + WS_LA); const float* LB = (const float*)(p->ws + WS_LB); const float* agg = (const float*)(p->ws + WS_AGG);
    const bf16_t* GG = (const bf16_t*)(p->ws + WS_GG); bf16_t* YC = (bf16_t*)(p->ws + WS_YCAT);
    for (int it = c; it < B * NLG; it += G) {
        const int b = it / NLG, grp = it % NLG; float h = 0.f;
        { float ga[NLG], gh[NLG];
#pragma unroll
          for (int q = 0; q < NLG - 1; ++q) { const size_t a0 = ((size_t)(b * NLG + q) * 2) * 512 + ch; const bool on = q < grp; ga[q] = on ? agg[a0] : 1.f; gh[q] = on ? agg[a0 + 512] : 0.f; }
#pragma unroll
          for (int q = 0; q < NLG - 1; ++q) h = ga[q] * h + gh[q]; }
        for (int pc = 0; pc < LG / 32; ++pc) {
            const size_t base = ((size_t)it * LG + pc * 32) * 512 + ch;
#pragma unroll
            for (int t0 = 0; t0 < 32; t0 += 16) {
                float av[16], bv[16]; unsigned short gv[16];
#pragma unroll
                for (int t = 0; t < 16; ++t) { av[t] = LA[base + (size_t)(t0 + t) * 512]; bv[t] = LB[base + (size_t)(t0 + t) * 512]; gv[t] = GG[base + (size_t)(t0 + t) * 512]; }
#pragma unroll
                for (int t = 0; t < 16; ++t) { h = av[t] * h + bv[t]; yb[(t0 + t) * 512 + ch] = h * bf2f(gv[t]); }
            }
            __syncthreads();
#pragma unroll
            for (int q = 0; q < 4; ++q) { const int t = wave + 8 * q; const f32x4 v0 = *(LAS f32x4*)(yb + t * 512 + lane * 8), v1 = *(LAS f32x4*)(yb + t * 512 + lane * 8 + 4);
                float s = (v0[0] * v0[0] + v0[1] * v0[1]) + (v0[2] * v0[2] + v0[3] * v0[3]) + (v1[0] * v1[0] + v1[1] * v1[1]) + (v1[2] * v1[2] + v1[3] * v1[3]);
                const float rs = rsqrtf(wave_sum(s) * (1.0f / 512.0f) + 1e-6f);
                *(u32x4*)(YC + ((size_t)it * LG + pc * 32 + t) * 1024 + 512 + lane * 8) = pack8(v0 * rs, v1 * rs); }
            __syncthreads();
        }
    }
}
__device__ __forceinline__ void p13_final_ln(KP p, int G, int c, int wv, float* dst) {
    const int lane = lane_id(), wave = wv; const float* st3 = (const float*)(p->ws + WS_STATS3);
    for (int row = c * 8 + wave; row < M; row += G * 8) {
        const f32x2 st = *(const f32x2*)(st3 + 2 * (size_t)row); const float mu = st.x * (1.0f / 1024.0f), rstd = rsqrtf(st.y * (1.0f / 1024.0f) - mu * mu + 1e-5f);
        float* o = p->out + (size_t)row * 1024;
#pragma unroll
        for (int j = 0; j < 4; ++j) { const f32x4 v = *(const f32x4*)(o + j * 256 + lane * 4), gg = *(const f32x4*)(p->in[37] + j * 256 + lane * 4), bb = *(const f32x4*)(p->in[38] + j * 256 + lane * 4);
            *(f32x4*)(dst + (size_t)row * 1024 + j * 256 + lane * 4) = (v - mu) * rstd * gg + bb; }
    }
}

constexpr int NPHASES = 14;
#define OSTATS(x) (x)
#define OUTP(x) (x)
#define DUMMYS(x) ((float*)(ws + 3 * MiB))
#define DUMMYO(x) ((float*)(ws + WS_V1))
#ifndef PH_MASK
#define PH_MASK 0x3fff
#endif
__global__ void __launch_bounds__(NTHREADS, 2) mega(Params p_unused) {
    extern __shared__ __attribute__((aligned(16))) unsigned char lds_raw[];
    LAS unsigned char* lds = (LAS unsigned char*)lds_raw;
    const int G = gridDim.x, c = blockIdx.x;
    unsigned char* ws; int lo, hi; { KP p = kargs(); ws = p->ws; lo = p->ph_lo; hi = p->ph_hi; }
#ifndef MK_CGSYNCS
#define MK_CGSYNCS (MK_MULTI ? 0 : 1)
#endif
    volatile LAS unsigned* bst = (volatile LAS unsigned*)(lds + LDS_BARW);
    const int wv = __builtin_amdgcn_readfirstlane((int)threadIdx.x >> 6);
    if (wv == 0 && lane_id() < 4) bst[lane_id()] = 0u;
    __syncthreads();
    XcdBarrier xbar; xbar.bar = (unsigned*)ws; xbar.x = 0; xbar.st = bst;
    if (hi - lo > 1) xbar = xcd_barrier_post((unsigned*)ws, bst, wv);
#define PH_END(k) if ((k) + 1 < hi) { if ((k) < MK_CGSYNCS) cg::this_grid().sync(); else xcd_barrier(xbar, wv); } else __syncthreads();
#if (PH_MASK >> 0) & 1
        if (lo <= 0 && 0 < hi) { KP p = kargs(); p0_prep(p, lds, G, c, wv); PH_END(0) }
#endif
#if (PH_MASK >> 1) & 1
        if (lo <= 1 && 1 < hi) { KP p = kargs(); {
            { PlainGeom<1024, 1024, M, DIN, 1024> g; g.A = (const bf16_t*)(ws + WS_H0B); g.Bt = (const bf16_t*)(ws + WS_WIN);
              EpiZ E; E.U = (bf16_t*)(ws + WS_U); E.XL = (bf16_t*)(ws + WS_XL); E.GG = (bf16_t*)(ws + WS_GG); gemm_phase(lds, g, E, G, c, wv); }
            { PlainGeom<1024, 1024, 4096, 1024, 1024> g; g.A = (const bf16_t*)(ws + WS_MEMN); g.Bt = (const bf16_t*)(ws + WS_WK);
              EpiBf16 E; E.O = (bf16_t*)(ws + WS_KMAT); E.ldc = 1024; E.bdiv = 1; E.ob0 = 0; E.ob1 = 0; gemm_phase(lds, g, E, G, c, wv); }
            { PlainGeom<1024, 1024, 1024, 4096, 1024> g; g.A = (const bf16_t*)(ws + WS_WV); g.Bt = (const bf16_t*)(ws + WS_MEMN);
              EpiBf16 E; E.O = (bf16_t*)(ws + WS_VT); E.ldc = 4096; E.bdiv = 1; E.ob0 = 0; E.ob1 = 0; gemm_phase(lds, g, E, G, (c + G - 64) % G, wv); }
        } PH_END(1) }
#endif
#if (PH_MASK >> 2) & 1
        if (lo <= 2 && 2 < hi) { KP p = kargs(); {
            { GeomT<640, 512, 8, 4, 1, NG, 256L * 640, 1024L * 640, 0, 1, 0, 256L * 512, 0, 0> g; g.A = (const bf16_t*)(ws + WS_U); g.Bt = (const bf16_t*)(ws + WS_S5P);
              EpiXend E; E.X = (float*)(ws + WS_XEND); gemm_phase(lds, g, E, G, c, wv); }
            { GeomT<512, 512, 8, 8, 1, 64, 256L * 512, 128, (long)XLROWS * 512, 16, 0, 256L * 512, 0, 1> g; g.A = (const bf16_t*)(ws + WS_XL); g.Bt = (const bf16_t*)(ws + WS_GATES);
              EpiGates E; E.XL = (const bf16_t*)(ws + WS_XL); E.cw = p->in[15]; E.cb = p->in[16]; E.gbias = (const float*)(ws + WS_GBIAS); E.sp8 = (const float*)(ws + WS_SP8);
              E.LA = (float*)(ws + WS_LA); E.LB = (float*)(ws + WS_LB); gemm_phase(lds, g, E, G, (c + G - 128) % G, wv); }
        } PH_END(2) }
#endif
#if (PH_MASK >> 3) & 1
        if (lo <= 3 && 3 < hi) { KP p = kargs(); p3_s5_scan(p, c, wv); p3_colsum_reduce(p, c, wv); p3_lru_pass1(p, G, G - 1 - c, wv); PH_END(3) }
#endif
#if (PH_MASK >> 4) & 1
        if (lo <= 4 && 4 < hi) { KP p = kargs(); {
            { GeomT<640, 640, 10, 4, 2, NG, 256L * 640, 1024L * 640, 0, 1, 256L * 640, 512L * 640, 0, 0> g; g.A = (const bf16_t*)(ws + WS_U); g.Bt = (const bf16_t*)(ws + WS_S5T);
              EpiS5 E; E.U = (const bf16_t*)(ws + WS_U); E.dd = p->in[12]; E.Y1 = (bf16_t*)(ws + WS_Y1); gemm_phase(lds, g, E, G, c, wv); }
            p4_lru_pass2(p, lds, G, c, wv);
        } PH_END(4) }
#endif
#if (PH_MASK >> 5) & 1
        if (lo <= 5 && 5 < hi) { KP p = kargs(); { PlainGeom<512, 512, M, 512, 512> g; g.A = (const bf16_t*)(ws + WS_Y1); g.Bt = (const bf16_t*)(ws + WS_WGLU);
            EpiGlu E; E.Y1 = (const bf16_t*)(ws + WS_Y1); E.bg = p->in[14]; E.YC = (bf16_t*)(ws + WS_YCAT); E.ssq = OSTATS((float*)(ws + WS_SSQ)); gemm_phase(lds, g, E, G, c, wv); } PH_END(5) }
#endif
#if (PH_MASK >> 6) & 1
        if (lo <= 6 && 6 < hi) { KP p = kargs(); { PlainGeom<1024, 1024, M, 1024, 1024> g; g.A = (const bf16_t*)(ws + WS_YCAT); g.Bt = (const bf16_t*)(ws + WS_WMIX);
            EpiRes<0, false, true, 8> E; E.prev = p->in[0]; E.prevb = nullptr; E.pstats = (const float*)(ws + WS_STATS0); E.pg = p->in[2]; E.pb_ = p->in[3]; E.vout = nullptr; E.vb = (bf16_t*)(ws + WS_V1B);
            E.ostats = OSTATS((float*)(ws + WS_STATS1)); E.ssq = (const float*)(ws + WS_SSQ); gemm_phase(lds, g, E, G, c, wv); } PH_END(6) }
#endif
#if (PH_MASK >> 7) & 1
        if (lo <= 7 && 7 < hi) { KP p = kargs(); { PlainGeom<1024, 1024, M, 1024, 1024> g; g.A = (const bf16_t*)(ws + WS_V1B); g.Bt = (const bf16_t*)(ws + WS_WQ);
            EpiFold<0> E; E.pstats = (const float*)(ws + WS_STATS1); E.c1 = (const float*)(ws + WS_C1Q); E.c2 = (const float*)(ws + WS_C2Q); E.O = (bf16_t*)(ws + WS_Q); E.ldc = 1024; E.sc = 0.0625f;
            gemm_phase(lds, g, E, G, c, wv); } PH_END(7) }
#endif
#if (PH_MASK >> 8) & 1
        if (lo <= 8 && 8 < hi) { KP p = kargs(); { GeomT<1024, 1024, 4, 8, 1, 64, 256L * 1024, 2048L * 1024, 256, 4, 0, 256L * 1024, 256, 0> g; g.A = (const bf16_t*)(ws + WS_Q); g.Bt = (const bf16_t*)(ws + WS_KMAT);
            EpiSoftmax E; E.P = (bf16_t*)(ws + WS_PROB); gemm_phase(lds, g, E, G, c, wv); } PH_END(8) }
#endif
#if (PH_MASK >> 9) & 1
        if (lo <= 9 && 9 < hi) { KP p = kargs(); { GeomT<256, 4096, 4, 8, 1, 64, 256L * 256, 4L * 2048 * 256, 2048L * 256, 4, 0, 256, 256L * 4096, 0> g; g.A = (const bf16_t*)(ws + WS_PROB); g.Bt = (const bf16_t*)(ws + WS_VT);
            EpiBf16 E; E.O = (bf16_t*)(ws + WS_AO); E.ldc = 1024; E.bdiv = 4; E.ob0 = 2048L * 1024; E.ob1 = 256; gemm_phase(lds, g, E, G, c, wv); } PH_END(9) }
#endif
#if (PH_MASK >> 10) & 1
        if (lo <= 10 && 10 < hi) { KP p = kargs(); { PlainGeom<1024, 1024, M, 1024, 1024> g; g.A = (const bf16_t*)(ws + WS_AO); g.Bt = (const bf16_t*)(ws + WS_WO);
            EpiRes<1, false, true, -1> E; E.prev = nullptr; E.prevb = (const bf16_t*)(ws + WS_V1B); E.pstats = (const float*)(ws + WS_STATS1); E.pg = p->in[25]; E.pb_ = p->in[26]; E.vout = nullptr; E.vb = (bf16_t*)(ws + WS_V1B);
            E.ostats = OSTATS((float*)(ws + WS_STATS2)); E.ssq = nullptr; gemm_phase(lds, g, E, G, c, wv); } PH_END(10) }
#endif
#if (PH_MASK >> 11) & 1
        if (lo <= 11 && 11 < hi) { KP p = kargs(); { PlainGeom<1024, 1024, M, DFF, 1024> g; g.A = (const bf16_t*)(ws + WS_V1B); g.Bt = (const bf16_t*)(ws + WS_WF1);
            EpiFold<1> E; E.pstats = (const float*)(ws + WS_STATS2); E.c1 = (const float*)(ws + WS_C1F); E.c2 = (const float*)(ws + WS_C2F); E.O = (bf16_t*)(ws + WS_HDN); E.ldc = DFF; E.sc = 1.f;
            gemm_phase(lds, g, E, G, c, wv); } PH_END(11) }
#endif
#if (PH_MASK >> 12) & 1
        if (lo <= 12 && 12 < hi) { KP p = kargs(); { PlainGeom<DFF, DFF, M, 1024, DFF> g; g.A = (const bf16_t*)(ws + WS_HDN); g.Bt = (const bf16_t*)(ws + WS_WF2);
            EpiRes<1, true, false, -1> E; E.prev = nullptr; E.prevb = (const bf16_t*)(ws + WS_V1B); E.pstats = (const float*)(ws + WS_STATS2); E.pg = p->in[33]; E.pb_ = p->in[34]; E.vout = p->out; E.vb = nullptr;
            E.ostats = OSTATS((float*)(ws + WS_STATS3)); E.ssq = nullptr; gemm_phase(lds, g, E, G, c, wv); } PH_END(12) }
#endif
#if (PH_MASK >> 13) & 1
        if (lo <= 13 && 13 < hi) { KP p = kargs(); p13_final_ln(p, G, c, wv, OUTP(p->out)); PH_END(13) }
#endif
#undef PH_END
}
}
#ifndef MK_MULTI
#define MK_MULTI 0
#endif
#ifndef MK_DEBUG
#define MK_DEBUG 0
#endif
#if MK_DEBUG
namespace dbg {
using namespace fp;
__device__ __forceinline__ float gelu_ref(float x) { const float k = 0.7978845608028654f; float u = k * (x + 0.044715f * x * x * x); return 0.5f * x * (1.0f + tanhf(u)); }
struct CmpArgs { const unsigned char* ws; const float* ref; const float* aux0; const float* aux1; int mode, rows, cols, ldr, bd; float* acc; };
__global__ void __launch_bounds__(256) k_cmp(CmpArgs a) {
    __shared__ float red[8];
    float d2 = 0.f, r2 = 0.f; const size_t n = (size_t)a.rows * a.cols;
    for (size_t i = (size_t)blockIdx.x * 256 + threadIdx.x; i < n; i += (size_t)gridDim.x * 256) {
        const int t = (int)(i / a.cols), c = (int)(i % a.cols); const size_t row = (size_t)a.bd * S + t;
        float f = 0.f, r = a.ref[(size_t)t * a.ldr + c];
        switch (a.mode) {
        case 1: { const int g = c >> 4, hi = c & 15; f = bf2f(((const bf16_t*)(a.ws + WS_U))[((size_t)(g * 1024 + a.bd * NCH + (t >> 5))) * 640 + (t & 31) * 16 + hi]); } break;
        case 2: f = bf2f(((const bf16_t*)(a.ws + WS_XL))[((size_t)(a.bd * XLROWS + 3 + t)) * 512 + c]); break;
        case 3: f = bf2f(((const bf16_t*)(a.ws + WS_GG))[row * 512 + c]); r = gelu_ref(r); break;
        case 4: f = bf2f(((const bf16_t*)(a.ws + WS_KMAT))[((size_t)(a.bd * 256 + t)) * 1024 + c]); break;
        case 5: f = bf2f(((const bf16_t*)(a.ws + WS_VT))[(size_t)c * 4096 + a.bd * 256 + t]); break;
        case 6: f = 1.0f - ((const float*)(a.ws + WS_LA))[row * 512 + c]; r = 1.0f - r; break;
        case 7: f = ((const float*)(a.ws + WS_LB))[row * 512 + c]; break;
        case 8: f = bf2f(((const bf16_t*)(a.ws + WS_Y1))[row * 512 + c]); break;
        case 9: f = bf2f(((const bf16_t*)(a.ws + WS_YCAT))[row * 1024 + 512 + c]) * a.aux0[c]; break;
        case 10: f = bf2f(((const bf16_t*)(a.ws + WS_YCAT))[row * 1024 + c]) * rsqrtf(((const float*)(a.ws + WS_SSQ))[row] * (1.0f / 512.0f) + 1e-6f) * a.aux0[c]; break;
        case 11: { const float* st = (const float*)(a.ws + WS_STATS1) + 2 * row; const float mu = st[0] * (1.0f / 1024.0f), rs = rsqrtf(st[1] * (1.0f / 1024.0f) - mu * mu + 1e-5f);
            f = (bf2f(((const bf16_t*)(a.ws + WS_V1B))[row * 1024 + c]) - mu) * rs * a.aux0[c] + a.aux1[c]; } break;
        case 12: f = 16.0f * bf2f(((const bf16_t*)(a.ws + WS_Q))[row * 1024 + c]); break;
        case 13: f = bf2f(((const bf16_t*)(a.ws + WS_AO))[row * 1024 + c]); break;
        case 14: { const float* st = (const float*)(a.ws + WS_STATS2) + 2 * row; const float mu = st[0] * (1.0f / 1024.0f), rs = rsqrtf(st[1] * (1.0f / 1024.0f) - mu * mu + 1e-5f);
            f = (bf2f(((const bf16_t*)(a.ws + WS_V1B))[row * 1024 + c]) - mu) * rs * a.aux0[c] + a.aux1[c]; } break;
        case 15: f = bf2f(((const bf16_t*)(a.ws + WS_HDN))[row * 4096 + c]); break;
        default: break;
        }
        const float d = f - r; d2 += d * d; r2 += r * r;
    }
    for (int o = 32; o > 0; o >>= 1) { d2 += __shfl_xor(d2, o); r2 += __shfl_xor(r2, o); }
    if ((threadIdx.x & 63) == 0) { red[(threadIdx.x >> 6) * 2] = d2; red[(threadIdx.x >> 6) * 2 + 1] = r2; }
    __syncthreads();
    if (threadIdx.x == 0) { atomicAdd(a.acc + a.mode * 2, red[0] + red[2] + red[4] + red[6]); atomicAdd(a.acc + a.mode * 2 + 1, red[1] + red[3] + red[5] + red[7]); }
}
__global__ void k_final(const float* acc, float* out, float tol) {
    if (threadIdx.x != 0 || blockIdx.x != 0) return;
    for (int m = 1; m <= 15; ++m) { const float d = acc[m * 2], r = acc[m * 2 + 1]; const float e = sqrtf(d / fmaxf(r, 1e-30f));
        if (!(e <= tol)) { float k = 1e4f; if (!(e < 0.1f)) k = 1e5f; if (!(e < 1.0f)) k = 1e6f; out[0] = (10.0f + m) * k; return; } }
}
}
#endif

extern "C" void kernel_launch(void* const* d_in, const int* in_sizes, int n_in, void* d_out, int out_size, void* d_ws, size_t ws_size, hipStream_t stream) {
    (void)in_sizes; (void)n_in; (void)out_size;
    static int grid = 0;
    if (grid == 0) {
        int dev = 0, cus = 0, per_cu = 0;
        hipGetDevice(&dev); hipDeviceGetAttribute(&cus, hipDeviceAttributeMultiprocessorCount, dev);
        hipFuncSetAttribute((const void*)fp::mega, hipFuncAttributeMaxDynamicSharedMemorySize, fp::LDS_BYTES);
        hipOccupancyMaxActiveBlocksPerMultiprocessor(&per_cu, (const void*)fp::mega, fp::NTHREADS, fp::LDS_BYTES);
        if (per_cu < 1) { fprintf(stderr, "kernel_launch: occupancy query says %d blocks/CU\n", per_cu); per_cu = 1; }
        grid = cus * 1;
        if (ws_size < fp::WS_END) fprintf(stderr, "kernel_launch: workspace too small: %zu < %zu\n", ws_size, (size_t)fp::WS_END);
        (void)hipGetLastError();
    }
    fp::Params p{};
    for (int i = 0; i < 39; ++i) p.in[i] = (const float*)d_in[i];
    p.out = (float*)d_out; p.ws = (unsigned char*)d_ws;
#if MK_DEBUG
    const int bd = 5;
    float* nws = (float*)d_out;
    float* f1x = nws + nv::naive_floats(1);
    float* acc = (float*)((unsigned char*)d_ws + fp::WS_DBG);
    hipMemsetAsync(acc, 0, 256, stream);
    nv::NaiveBufs NB = nv::run_naive(d_in, nullptr, nws, stream, bd, 1, 9, f1x);
    const float* z = NB.big; const float* xc = z + (size_t)nv::S * 1536; const float* pa = xc + (size_t)nv::S * 512; const float* px = pa + (size_t)nv::S * 512;
    const float* ylru = px + (size_t)nv::S * 512; const float* ys = ylru + (size_t)nv::S * 512; (void)ylru;
    auto cmp = [&](int mode, const float* ref, int rows, int cols, int ldr, const float* a0, const float* a1) {
        dbg::CmpArgs a{(const unsigned char*)d_ws, ref, a0, a1, mode, rows, cols, ldr, bd, acc};
        hipLaunchKernelGGL(dbg::k_cmp, dim3(512), dim3(256), 0, stream, a); };
    auto phase = [&](int ph) { p.ph_lo = ph; p.ph_hi = ph + 1; hipLaunchKernelGGL(fp::mega, dim3(grid), dim3(fp::NTHREADS), fp::LDS_BYTES, stream, p); };
    auto fin = (const float* const*)d_in;
    phase(0); phase(1);
    cmp(1, z, 2048, 512, 1536, nullptr, nullptr); cmp(2, z + 512, 2048, 512, 1536, nullptr, nullptr); cmp(3, z + 1024, 2048, 512, 1536, nullptr, nullptr);
    cmp(4, NB.Km, 256, 1024, 1024, nullptr, nullptr); cmp(5, NB.Vm, 256, 1024, 1024, nullptr, nullptr);
    phase(2);
    cmp(6, pa, 2048, 512, 512, nullptr, nullptr); cmp(7, px, 2048, 512, 512, nullptr, nullptr);
    phase(3); phase(4);
    cmp(8, ys, 2048, 512, 512, nullptr, nullptr); cmp(9, NB.ycat + 512, 2048, 512, 1024, fin[23], nullptr);
    phase(5);
    cmp(10, NB.ycat, 2048, 512, 1024, fin[22], nullptr);
    phase(6);
    cmp(11, NB.h1, 2048, 1024, 1024, fin[25], fin[26]);
    phase(7);
    cmp(12, NB.q, 2048, 1024, 1024, nullptr, nullptr);
    phase(8); phase(9);
    cmp(13, NB.ao, 2048, 1024, 1024, nullptr, nullptr);
    phase(10);
    cmp(14, NB.h2, 2048, 1024, 1024, fin[33], fin[34]);
    phase(11);
    cmp(15, f1x, 2048, 4096, 4096, nullptr, nullptr);
    phase(12); phase(13);
    hipLaunchKernelGGL(dbg::k_final, dim3(1), dim3(64), 0, stream, (const float*)acc, (float*)d_out, 0.03f);
#elif MK_MULTI
    for (int ph = 0; ph < fp::NPHASES; ++ph) { p.ph_lo = ph; p.ph_hi = ph + 1; hipLaunchKernelGGL(fp::mega, dim3(grid), dim3(fp::NTHREADS), fp::LDS_BYTES, stream, p); }
#else
    p.ph_lo = 0; p.ph_hi = fp::NPHASES;
    (void)hipMemsetAsync(d_ws, 0, 16384, stream);
    void* args[] = {&p};
    hipError_t e = hipLaunchCooperativeKernel((const void*)fp::mega, dim3(grid), dim3(fp::NTHREADS), args, fp::LDS_BYTES, stream);
    if (e != hipSuccess) fprintf(stderr, "cooperative launch failed: %s (grid %d)\n", hipGetErrorString(e), grid);
#endif
}
```
